# Optimizing an MI355X kernel written in HIP

```python
import math
import jax
import jax.numpy as jnp
from jax import lax
import numpy as np

D_MODEL = 1024
BATCH = 8
SEQ = 2048
DEPTH = 2

RW_HEADS = 8
RW_HEAD_DIM = 64
RW_WIDTH = RW_HEADS * RW_HEAD_DIM
RW_DECAY_RANK = 64
RW_ICLR_RANK = 64
RW_GATE_RANK = 160
RW_GN_EPS = 64e-5
RW_PROJ = 3 * RW_WIDTH + RW_DECAY_RANK + RW_ICLR_RANK + RW_GATE_RANK
SC_WIDTH = 512
SC_CONV = 3
SC_PROJ = 3 * SC_WIDTH
AB_PROJ = RW_PROJ + SC_PROJ
AB_OUT_IN = RW_WIDTH + SC_WIDTH
DIL_PATTERNS = ((128, 1), (512, 4), (2048, 16))
N_GROUPS = 3
DIL_HEADS = 8
DIL_HEAD_DIM = 64
DIL_WIDTH = DIL_HEADS * DIL_HEAD_DIM
DIL_PROJ = N_GROUPS * 3 * DIL_WIDTH
BLOCK = 128
N_BUCKETS = 32
MAX_DISTANCE = 2048
D_FF = 4 * D_MODEL
N_EVEN = (DEPTH + 1) // 2
N_ODD = DEPTH // 2
DEEPNORM_ALPHA = (2 * DEPTH) ** 0.25
DEEPNORM_BETA = (8 * DEPTH) ** -0.25
LN_EPS = 1e-5

kernel_name = 'hybrid_rwkv7_shortconv_dilated_attn_trunk'


def _layer_norm(x, g, b):
    xf = x.astype(jnp.float32)
    mu = jnp.mean(xf, -1, keepdims=True)
    var = jnp.mean(jnp.square(xf - mu), -1, keepdims=True)
    return ((xf - mu) * lax.rsqrt(var + LN_EPS) * g + b).astype(x.dtype)


def _token_shift(p):
    return jnp.pad(p, ((0, 0), (1, 0), (0, 0)))[:, :-1]


def _rwkv7_step(state, inp):
    r, w, k, v, a, b = inp
    sa = jnp.einsum('bhvk,bhk->bhv', state, a)
    state = state * w[:, :, None, :] + sa[..., None] * b[:, :, None, :] + v[..., None] * k[:, :, None, :]
    return state, jnp.einsum('bhvk,bhk->bhv', state, r)


def _causal_depthwise_conv(z, w):
    return lax.conv_general_dilated(z, w[:, None, :].astype(z.dtype), window_strides=(1,),
                                    padding=((SC_CONV - 1, 0),),
                                    dimension_numbers=('NWC', 'WIO', 'NWC'),
                                    feature_group_count=z.shape[-1])


def rwkv_shortconv_mixer(u, w_in, mu, w0, w_up, a0, a_up, g_up, k_k, k_a, r_k, lnx_g, lnx_b, conv_w, w_out):
    f32 = jnp.float32
    B, T, _ = u.shape
    p = u @ w_in
    pa, pb = p[..., :RW_PROJ], p[..., RW_PROJ:]
    pa = pa + mu * (_token_shift(pa) - pa)
    W = RW_WIDTH
    r, k, v, wd, ad, gd = jnp.split(
        pa, [W, 2 * W, 3 * W, 3 * W + RW_DECAY_RANK, 3 * W + RW_DECAY_RANK + RW_ICLR_RANK], axis=-1)
    logw = -jax.nn.softplus(-(w0 + jnp.tanh(wd) @ w_up).astype(f32)) - 0.5
    decay = jnp.exp(-jnp.exp(logw))
    iclr = jax.nn.sigmoid((a0 + ad @ a_up).astype(f32))
    gate = (jax.nn.sigmoid(gd) @ g_up).astype(f32)

    def heads(t):
        return t.astype(f32).reshape(B, T, RW_HEADS, RW_HEAD_DIM)

    kf = k.astype(f32)
    kk = heads(kf * k_k)
    kk = kk / jnp.maximum(jnp.linalg.norm(kk, axis=-1, keepdims=True), 1e-12)
    k_h = heads(kf * (1.0 + (iclr - 1.0) * k_a))
    r_h, v_h, w_h, a_h = heads(r), heads(v), heads(decay), heads(iclr)
    xs = tuple(jnp.moveaxis(t, 1, 0) for t in (r_h, w_h, k_h, v_h, -kk, kk * a_h))
    s0 = jnp.zeros((B, RW_HEADS, RW_HEAD_DIM, RW_HEAD_DIM), f32)
    _, y = lax.scan(_rwkv7_step, s0, xs)
    y = jnp.moveaxis(y, 0, 1)
    mean = jnp.mean(y, -1, keepdims=True)
    var = jnp.mean(jnp.square(y - mean), -1, keepdims=True)
    y = ((y - mean) * lax.rsqrt(var + RW_GN_EPS)).reshape(B, T, W) * lnx_g + lnx_b
    bonus = jnp.sum(r_h * k_h * r_k, -1, keepdims=True) * v_h
    y_a = ((y + bonus.reshape(B, T, W)) * gate).astype(u.dtype)
    h, b_gate, c_gate = jnp.split(pb, 3, axis=-1)
    y_b = b_gate * _causal_depthwise_conv(c_gate * h, conv_w)
    return jnp.concatenate([y_a, y_b], axis=-1) @ w_out


def _t5_bucket(dist):
    exact = N_BUCKETS // 2
    logd = jnp.log(jnp.maximum(dist, 1).astype(jnp.float32) / exact) / math.log(MAX_DISTANCE / exact)
    large = jnp.minimum(exact + (logd * (N_BUCKETS - exact)).astype(jnp.int32), N_BUCKETS - 1)
    return jnp.where(dist < exact, dist, large)


def _to_blocks(x, dil, nb):
    b, t = x.shape[:2]
    rest = x.shape[2:]
    L = t // dil
    x = jnp.moveaxis(x.reshape((b, L, dil) + rest), 2, 1)
    pad = [(0, 0)] * x.ndim
    pad[2] = (0, nb * BLOCK - L)
    return jnp.pad(x, pad).reshape((b, dil, nb, BLOCK) + rest)


def _from_blocks(x, L):
    b, dil, nb, blk = x.shape[:4]
    rest = x.shape[4:]
    x = x.reshape((b, dil, nb * blk) + rest)[:, :, :L]
    return jnp.moveaxis(x, 1, 2).reshape((b, L * dil) + rest)


def _with_prev_block(xb):
    prev = jnp.pad(xb, ((0, 0), (0, 0), (1, 0)) + ((0, 0),) * (xb.ndim - 3))[:, :, :-1]
    return jnp.concatenate([prev, xb], axis=3)


def _dilated_group_attention(q, k, v, bias, band, dil):
    t = q.shape[1]
    L = t // dil
    nb = -(-L // BLOCK)
    qb = _to_blocks(q, dil, nb)
    kc = _with_prev_block(_to_blocks(k, dil, nb))
    vc = _with_prev_block(_to_blocks(v, dil, nb))
    s = jnp.einsum('brnqhd,brnkhd->brnhqk', qb, kc).astype(jnp.float32) * (DIL_HEAD_DIM ** -0.5) + bias
    kidx = jnp.arange(2 * BLOCK)
    not_pad = (jnp.arange(nb) > 0)[:, None, None] | (kidx >= BLOCK)[None, None, :]
    valid = (band[None] & not_pad)[None, None, :, None]
    s = jnp.where(valid, s, -jnp.inf)
    m = jnp.max(s, -1, keepdims=True)
    e = jnp.exp(s - m)
    den = jnp.sum(e, -1, keepdims=True)
    o = jnp.einsum('brnhqk,brnkhd->brnqhd', (e / den).astype(v.dtype), vc)
    lse = jnp.moveaxis((m + jnp.log(den))[..., 0], 3, 4)
    return _from_blocks(o, L), _from_blocks(lse, L)


def dilated_attention_mixer(u, w_qkv, w_out, rel_bias):
    B, T, _ = u.shape
    p = (u @ w_qkv).reshape(B, T, N_GROUPS, 3, DIL_HEADS, DIL_HEAD_DIM)
    qi = jnp.arange(BLOCK)[:, None]
    ki = jnp.arange(2 * BLOCK)[None, :]
    rel = BLOCK + qi - ki
    outs, lses = [], []
    for g, (window, dil) in enumerate(DIL_PATTERNS):
        span = window // dil
        band = (rel >= 0) & (rel <= span)
        bucket = _t5_bucket(jnp.clip(rel, 0, span) * dil)
        bias = jnp.transpose(rel_bias[bucket][..., g * DIL_HEADS:(g + 1) * DIL_HEADS], (2, 0, 1)).astype(jnp.float32)
        o, lse = _dilated_group_attention(p[:, :, g, 0], p[:, :, g, 1], p[:, :, g, 2], bias, band, dil)
        outs.append(o.astype(jnp.float32))
        lses.append(lse)
    wts = jax.nn.softmax(jnp.stack(lses), axis=0)
    o = jnp.sum(wts[..., None] * jnp.stack(outs), axis=0)
    return o.reshape(B, T, DIL_WIDTH).astype(u.dtype) @ w_out


def sq_relu_mlp(u, w1, w2):
    return jnp.square(jax.nn.relu(u @ w1)) @ w2


def setup_inputs(seed: int = 0) -> dict:
    key = jax.random.key(seed)
    ks = iter(jax.random.split(key, 32))
    D = D_MODEL

    def nrm(shape, s):
        return s * jax.random.normal(next(ks), shape, jnp.float32)

    return {
        'x': nrm((BATCH, SEQ, D), 1.0),
        'c': nrm((BATCH, D), 1.0),
        'ada_w': nrm((DEPTH, D, 6 * D), 0.1 * D ** -0.5),
        'ada_b': nrm((DEPTH, 6 * D), 0.01),
        'ln_g': 1.0 + nrm((DEPTH, 2, D), 0.02),
        'ln_b': nrm((DEPTH, 2, D), 0.02),
        'ab_w_in': nrm((N_EVEN, D, AB_PROJ), D ** -0.5),
        'rw_mu': jax.random.uniform(next(ks), (N_EVEN, RW_PROJ), jnp.float32),
        'rw_w0': -2.0 + nrm((N_EVEN, RW_WIDTH), 1.0),
        'rw_w_up': nrm((N_EVEN, RW_DECAY_RANK, RW_WIDTH), RW_DECAY_RANK ** -0.5),
        'rw_a0': nrm((N_EVEN, RW_WIDTH), 0.5),
        'rw_a_up': nrm((N_EVEN, RW_ICLR_RANK, RW_WIDTH), RW_ICLR_RANK ** -0.5),
        'rw_g_up': nrm((N_EVEN, RW_GATE_RANK, RW_WIDTH), RW_GATE_RANK ** -0.5),
        'rw_k_k': 0.85 + nrm((N_EVEN, RW_WIDTH), 0.05),
        'rw_k_a': 1.0 + nrm((N_EVEN, RW_WIDTH), 0.05),
        'rw_r_k': nrm((N_EVEN, RW_HEADS, RW_HEAD_DIM), 0.1),
        'rw_lnx_g': 1.0 + nrm((N_EVEN, RW_WIDTH), 0.02),
        'rw_lnx_b': nrm((N_EVEN, RW_WIDTH), 0.02),
        'sc_conv_w': nrm((N_EVEN, SC_CONV, SC_WIDTH), SC_CONV ** -0.5),
        'ab_w_out': nrm((N_EVEN, AB_OUT_IN, D), DEEPNORM_BETA * AB_OUT_IN ** -0.5),
        'dil_w_qkv': nrm((N_ODD, D, DIL_PROJ), D ** -0.5),
        'dil_w_out': nrm((N_ODD, DIL_WIDTH, D), DEEPNORM_BETA * DIL_WIDTH ** -0.5),
        'rel_bias': nrm((N_BUCKETS, N_GROUPS * DIL_HEADS), 0.5),
        'mlp_w1': nrm((DEPTH, D, D_FF), D ** -0.5),
        'mlp_w2': nrm((DEPTH, D_FF, D), DEEPNORM_BETA * D_FF ** -0.5),
    }


def reference(x, c, ada_w, ada_b, ln_g, ln_b, ab_w_in, rw_mu, rw_w0, rw_w_up, rw_a0, rw_a_up, rw_g_up,
              rw_k_k, rw_k_a, rw_r_k, rw_lnx_g, rw_lnx_b, sc_conv_w, ab_w_out, dil_w_qkv, dil_w_out,
              rel_bias, mlp_w1, mlp_w2):
    cond = jax.nn.silu(c)
    for i in range(DEPTH):
        mod = (cond @ ada_w[i] + ada_b[i])[:, None, :]
        sh1, sc1, g1, sh2, sc2, g2 = jnp.split(mod, 6, axis=-1)
        j = i // 2
        u = x * (1 + sc1) + sh1
        if i % 2 == 0:
            y = rwkv_shortconv_mixer(u, ab_w_in[j], rw_mu[j], rw_w0[j], rw_w_up[j], rw_a0[j], rw_a_up[j],
                                     rw_g_up[j], rw_k_k[j], rw_k_a[j], rw_r_k[j], rw_lnx_g[j], rw_lnx_b[j],
                                     sc_conv_w[j], ab_w_out[j])
        else:
            y = dilated_attention_mixer(u, dil_w_qkv[j], dil_w_out[j], rel_bias)
        x = _layer_norm(DEEPNORM_ALPHA * x + (1 + g1) * y, ln_g[i, 0], ln_b[i, 0])
        u = x * (1 + sc2) + sh2
        y = sq_relu_mlp(u, mlp_w1[i], mlp_w2[i])
        x = _layer_norm(DEEPNORM_ALPHA * x + (1 + g2) * y, ln_g[i, 1], ln_b[i, 1])
    return x
```

```cpp
#include <hip/hip_runtime.h>
#include <cstdio>
#include <cstdint>
#define MK_SINGLE 1
namespace pg8 {
#define PG8_LAS __attribute__((address_space(3)))
typedef unsigned short bf16_t;
typedef short bf16x8 __attribute__((ext_vector_type(8)));
typedef float f32x4 __attribute__((ext_vector_type(4)));
typedef unsigned u32x4 __attribute__((ext_vector_type(4)));
constexpr int BM = 256, BK = 64, HALF = 128, HTB = HALF * BK * 2  , STAGE_BYTES = 8 * HTB, NXCD = 8, WGM = 8;

__host__ __device__ __forceinline__ int lds_byte(int r, int c) { const int st = (r >> 4) * 2 + (c >> 5), rr = r & 15, cc = c & 31, ob = rr * 64 + cc * 2; return st * 1024 + (ob ^ (((ob >> 9) & 1) << 5)); }
__host__ __device__ __forceinline__ void stage_rc(int b, int& R, int& C) { const int st = b / 1024, sb = b % 1024, swz = sb ^ (((sb >> 9) & 1) << 5); R = (st >> 1) * 16 + swz / 64; C = (st & 1) * 32 + (swz % 64) / 2; }
__host__ __device__ __forceinline__ int perm32(int rho) { const int n = rho >> 4, i = rho & 15; return 8 * (i >> 2) + 4 * n + (i & 3); }

struct Unit { int pm, pn; };
struct Gemm { const bf16_t* A; const bf16_t* Bt; int M, N, K; };

struct StaticOrder {
    int nM, nN, nwg, G, c;
    __host__ __device__ void init(int M, int N, int G_, int c_) { nM = M / BM; nN = N / BM; nwg = nM * nN; G = G_; c = c_; }
    __host__ __device__ bool next(int i, Unit& u) const {
        const long L = (long)i * G + c; if (L >= nwg) return false;
        int wgid = (int)L; { const int q = nwg / NXCD, r = nwg % NXCD, xcd = wgid % NXCD, off = wgid / NXCD; wgid = (xcd < r ? xcd * (q + 1) : r * (q + 1) + (xcd - r) * q) + off; }
        const int nig = WGM * nN, gid = wgid / nig, fm = gid * WGM, gsz = (nM - fm) < WGM ? (nM - fm) : WGM;
        u.pm = fm + ((wgid % nig) % gsz); u.pn = (wgid % nig) / gsz; return true;
    }
    __device__ __forceinline__ void a_ready(const Unit&) const {}
    __device__ __forceinline__ void done(const Unit&) const {}
};


__device__ __forceinline__ unsigned cvt_pk_bf16(float lo, float hi) { unsigned r; asm volatile("v_cvt_pk_bf16_f32 %0, %1, %2" : "=v"(r) : "v"(lo), "v"(hi)); return r; }

template <int ACT> struct EpiBf16 {
    static constexpr bool PERM = true, AFTER_DRAIN = false;
    bf16_t* O; int ldc;
    __device__ __forceinline__ void operator()(const f32x4 (&acc)[2][2][4][2], const Unit& u, int wr, int wc, int fr, int fq) const {
        const int row0 = u.pm * BM + wr * 64 + fr, col0 = u.pn * BM + wc * 32 + 8 * fq;
#pragma unroll
        for (int ai = 0; ai < 2; ++ai)
#pragma unroll
            for (int m = 0; m < 4; ++m) { bf16_t* rowp = O + (size_t)(row0 + ai * HALF + m * 16) * ldc + col0;
#pragma unroll
                for (int bj = 0; bj < 2; ++bj) { f32x4 v0 = acc[ai][bj][m][0], v1 = acc[ai][bj][m][1];
                    if (ACT == 1) {
#pragma unroll
                        for (int e = 0; e < 4; ++e) { const float a = fmaxf(v0[e], 0.f), b = fmaxf(v1[e], 0.f); v0[e] = a * a; v1[e] = b * b; } }
                    u32x4 w; w.x = cvt_pk_bf16(v0[0], v0[1]); w.y = cvt_pk_bf16(v0[2], v0[3]); w.z = cvt_pk_bf16(v1[0], v1[1]); w.w = cvt_pk_bf16(v1[2], v1[3]);
                    *(u32x4*)(rowp + bj * HALF) = w; } }
    }
};

struct EpiF32 {
    static constexpr bool PERM = false, AFTER_DRAIN = false;
    float* C; int ldc;
    __device__ __forceinline__ void operator()(const f32x4 (&acc)[2][2][4][2], const Unit& u, int wr, int wc, int fr, int fq) const {
        const int row0 = u.pm * BM + wr * 64 + fr, col0 = u.pn * BM + wc * 32 + 4 * fq;
#pragma unroll
        for (int ai = 0; ai < 2; ++ai)
#pragma unroll
            for (int m = 0; m < 4; ++m) { float* rowp = C + (size_t)(row0 + ai * HALF + m * 16) * ldc + col0;
#pragma unroll
                for (int bj = 0; bj < 2; ++bj)
#pragma unroll
                    for (int n = 0; n < 2; ++n) *(f32x4*)(rowp + bj * HALF + n * 16) = acc[ai][bj][m][n]; }
    }
};

struct EpiLow {
    static constexpr bool PERM = true, AFTER_DRAIN = false;
    bf16_t* O; int ldc; const float* w0; const float* a0;
    __device__ __forceinline__ void operator()(const f32x4 (&acc)[2][2][4][2], const Unit& u, int wr, int wc, int fr, int fq) const {
        const int row0 = u.pm * BM + wr * 64 + fr, col0 = u.pn * BM + wc * 32 + 8 * fq;
        const int typ = u.pn >> 1, pc0 = (u.pn & 1) * BM + wc * 32 + 8 * fq;
        const float* par = (typ == 0 ? w0 : a0) + pc0;
        const float sc = typ == 0 ? 0.6065306597126334f : 1.0f;
#pragma unroll
        for (int bj = 0; bj < 2; ++bj) {
            f32x4 b0 = (f32x4){0.f, 0.f, 0.f, 0.f}, b1 = b0;
            if (typ < 2) { b0 = *(const f32x4*)(par + bj * HALF); b1 = *(const f32x4*)(par + bj * HALF + 4); }
#pragma unroll
            for (int ai = 0; ai < 2; ++ai)
#pragma unroll
                for (int m = 0; m < 4; ++m) { bf16_t* rowp = O + (size_t)(row0 + ai * HALF + m * 16) * ldc + col0;
                    f32x4 v0 = acc[ai][bj][m][0] + b0, v1 = acc[ai][bj][m][1] + b1;
                    if (typ < 2) {
#pragma unroll
                        for (int e = 0; e < 4; ++e) { v0[e] = sc / (1.f + __expf(-v0[e])); v1[e] = sc / (1.f + __expf(-v1[e])); } }
                    u32x4 w; w.x = cvt_pk_bf16(v0[0], v0[1]); w.y = cvt_pk_bf16(v0[2], v0[3]); w.z = cvt_pk_bf16(v1[0], v1[1]); w.w = cvt_pk_bf16(v1[2], v1[3]);
                    *(u32x4*)(rowp + bj * HALF) = w; }
        }
    }
};

template <class Epi, class Sched, bool ALIGN_EPI = false, bool SP2 = false>
__device__ __forceinline__ void gemm_phase(PG8_LAS unsigned char* lds, const Gemm g, const Sched& S, const Epi& E) {
    const int tid = threadIdx.x, wid = __builtin_amdgcn_readfirstlane(tid >> 6), lane = tid & 63, wr = wid >> 2, wc = wid & 3, fr = lane & 15, fq = lane >> 4;
    const int K = g.K, nt = K / BK;
    unsigned voffA[2], voffB[2];
#pragma unroll
    for (int i = 0; i < 2; ++i) { int R, C; stage_rc(tid * 16 + i * 8192, R, C); const int Rb = Epi::PERM ? ((R & ~31) + perm32(R & 31)) : R;
        voffA[i] = (unsigned)(R * K + C) * 2u; voffB[i] = (unsigned)(Rb * K + C) * 2u; }
    const size_t kstep = (size_t)(BK * 2);
    const size_t hstep = (size_t)HALF * K * 2;
    const size_t tstep = 2 * hstep;
    const unsigned ldsw = (unsigned)wid * 1024u;
    const int aoff = lds_byte(wr * 64 + fr, fq * 8), boff = lds_byte(wc * 32 + fr, fq * 8);
#define PG8_SA(b, h) (((b) * 2 + (h)) * HTB)
#define PG8_SB(b, h) ((4 + (b) * 2 + (h)) * HTB)
#define PG8_STAGE(bufoff, gbase, voff) do { _Pragma("unroll") for (int _i = 0; _i < 2; ++_i) \
        __builtin_amdgcn_global_load_lds((const unsigned*)((const char*)(gbase) + (voff)[_i]), (PG8_LAS unsigned*)(lds + (bufoff) + ldsw + _i * 8192), 16, 0, 0); } while (0)
#define PG8_LDA(dst, b, h) do { _Pragma("unroll") for (int m = 0; m < 4; ++m) _Pragma("unroll") for (int k = 0; k < 2; ++k) dst[m][k] = *(const PG8_LAS bf16x8*)(lds + PG8_SA(b, h) + aoff + m * 2048 + k * 1024); } while (0)
#define PG8_LDB(dst, b, h) do { _Pragma("unroll") for (int n = 0; n < 2; ++n) _Pragma("unroll") for (int k = 0; k < 2; ++k) dst[n][k] = *(const PG8_LAS bf16x8*)(lds + PG8_SB(b, h) + boff + n * 2048 + k * 1024); } while (0)
#define PG8_MMA(ai, bj, At, Bt) do { __builtin_amdgcn_s_setprio(1); _Pragma("unroll") for (int m = 0; m < 4; ++m) _Pragma("unroll") for (int n = 0; n < 2; ++n) _Pragma("unroll") for (int k = 0; k < 2; ++k) \
        acc[ai][bj][m][n] = __builtin_amdgcn_mfma_f32_16x16x32_bf16(Bt[n][k], At[m][k], acc[ai][bj][m][n], 0, 0, 0); __builtin_amdgcn_s_setprio(0); } while (0)
#define PG8_WAIT_V(n) asm volatile("s_waitcnt vmcnt(" #n ")" ::: "memory")
#define PG8_WAIT_L(n) asm volatile("s_waitcnt lgkmcnt(" #n ")" ::: "memory")
#define PG8_BAR __builtin_amdgcn_s_barrier()
#define PG8_SCHED __builtin_amdgcn_sched_barrier(0)
    Unit cur, nxt; int ui = 0;
    if (!S.next(0, cur)) return;
    f32x4 acc[2][2][4][2];
#pragma unroll
    for (int a = 0; a < 2; ++a)
#pragma unroll
        for (int b = 0; b < 2; ++b)
#pragma unroll
            for (int m = 0; m < 4; ++m)
#pragma unroll
                for (int n = 0; n < 2; ++n) acc[a][b][m][n] = (f32x4){0.f, 0.f, 0.f, 0.f};
    bf16x8 At[4][2], B0[2][2], B1[2][2];
    const char* cA = (const char*)g.A + (size_t)cur.pm * tstep; const char* cB = (const char*)g.Bt + (size_t)cur.pn * tstep;
    S.a_ready(cur);
    if constexpr (SP2) {
        PG8_STAGE(PG8_SB(0, 0), cB, voffB); PG8_STAGE(PG8_SB(0, 1), cB + hstep, voffB); PG8_STAGE(PG8_SA(0, 0), cA, voffA); PG8_STAGE(PG8_SA(0, 1), cA + hstep, voffA);
        if (wr == 1) PG8_BAR;
        PG8_WAIT_V(2); PG8_BAR;
        PG8_STAGE(PG8_SB(1, 0), cB + kstep, voffB); PG8_STAGE(PG8_SA(1, 0), cA + kstep, voffA); PG8_STAGE(PG8_SB(1, 1), cB + hstep + kstep, voffB);
        PG8_WAIT_V(6); PG8_BAR;
    } else {
        PG8_STAGE(PG8_SB(0, 0), cB, voffB); PG8_STAGE(PG8_SA(0, 0), cA, voffA); PG8_STAGE(PG8_SB(0, 1), cB + hstep, voffB); PG8_STAGE(PG8_SA(0, 1), cA + hstep, voffA);
        if (wr == 1) PG8_BAR;
        PG8_WAIT_V(4); PG8_BAR;
        PG8_STAGE(PG8_SB(1, 0), cB + kstep, voffB); PG8_STAGE(PG8_SA(1, 0), cA + kstep, voffA); PG8_STAGE(PG8_SB(1, 1), cB + hstep + kstep, voffB);
        PG8_WAIT_V(6); PG8_BAR;
    }
    for (;;) {
        const bool has_next = S.next(ui + 1, nxt);
        const char* nA = has_next ? (const char*)g.A + (size_t)nxt.pm * tstep : cA; const char* nB = has_next ? (const char*)g.Bt + (size_t)nxt.pn * tstep : cB;
#pragma nounroll
        for (int t = 0; t < nt; t += 2) {
            const bool last = (t == nt - 2);
            const char* a1 = cA + (size_t)(t + 1) * kstep;
            const char* a2 = last ? nA : cA + (size_t)(t + 2) * kstep; const char* b2 = last ? nB : cB + (size_t)(t + 2) * kstep;
            const char* a3 = a2 + kstep; const char* b3 = b2 + kstep;
            if (last && has_next) S.a_ready(nxt);
            if constexpr (SP2) {
            PG8_LDB(B0, 0, 0); PG8_LDB(B1, 0, 1); PG8_SCHED; PG8_LDA(At, 0, 0); PG8_STAGE(PG8_SA(1, 1), a1 + hstep, voffA);
            PG8_WAIT_V(8); PG8_WAIT_L(0); PG8_BAR; PG8_MMA(0, 0, At, B0); PG8_MMA(0, 1, At, B1); PG8_BAR; PG8_SCHED;
            PG8_LDA(At, 0, 1); PG8_STAGE(PG8_SB(0, 0), b2, voffB); PG8_STAGE(PG8_SB(0, 1), b2 + hstep, voffB); PG8_STAGE(PG8_SA(0, 0), a2, voffA);
            PG8_WAIT_V(8); PG8_WAIT_L(0); PG8_BAR; PG8_MMA(1, 0, At, B0); PG8_MMA(1, 1, At, B1); PG8_BAR; PG8_SCHED;
            PG8_LDB(B0, 1, 0); PG8_LDB(B1, 1, 1); PG8_SCHED; PG8_LDA(At, 1, 0); PG8_STAGE(PG8_SA(0, 1), a2 + hstep, voffA);
            PG8_WAIT_V(8); PG8_WAIT_L(0); PG8_BAR; PG8_MMA(0, 0, At, B0); PG8_MMA(0, 1, At, B1); PG8_BAR; PG8_SCHED;
            PG8_LDA(At, 1, 1); PG8_STAGE(PG8_SB(1, 0), b3, voffB); PG8_STAGE(PG8_SB(1, 1), b3 + hstep, voffB); PG8_STAGE(PG8_SA(1, 0), a3, voffA);
            PG8_WAIT_V(8); PG8_WAIT_L(0); PG8_BAR; PG8_MMA(1, 0, At, B0); PG8_MMA(1, 1, At, B1); PG8_BAR; PG8_SCHED;
            } else {
            PG8_LDB(B0, 0, 0); PG8_SCHED; PG8_LDA(At, 0, 0); PG8_STAGE(PG8_SA(1, 1), a1 + hstep, voffA);
            PG8_WAIT_L(8); PG8_BAR; PG8_WAIT_L(0); PG8_MMA(0, 0, At, B0); PG8_BAR; PG8_SCHED;
            PG8_LDB(B1, 0, 1); PG8_STAGE(PG8_SB(0, 0), b2, voffB);
            PG8_BAR; PG8_WAIT_L(0); PG8_MMA(0, 1, At, B1); PG8_BAR;
            PG8_LDA(At, 0, 1); PG8_STAGE(PG8_SA(0, 0), a2, voffA);
            PG8_BAR; PG8_WAIT_L(0); PG8_MMA(1, 0, At, B0); PG8_BAR; PG8_SCHED;
            PG8_STAGE(PG8_SB(0, 1), b2 + hstep, voffB);
            PG8_WAIT_V(6); PG8_BAR; PG8_MMA(1, 1, At, B1); PG8_BAR;
            PG8_LDB(B0, 1, 0); PG8_SCHED; PG8_LDA(At, 1, 0); PG8_STAGE(PG8_SA(0, 1), a2 + hstep, voffA);
            PG8_WAIT_L(8); PG8_BAR; PG8_WAIT_L(0); PG8_MMA(0, 0, At, B0); PG8_BAR; PG8_SCHED;
            PG8_LDB(B1, 1, 1); PG8_STAGE(PG8_SB(1, 0), b3, voffB);
            PG8_BAR; PG8_WAIT_L(0); PG8_MMA(0, 1, At, B1); PG8_BAR;
            PG8_LDA(At, 1, 1); PG8_STAGE(PG8_SA(1, 0), a3, voffA);
            PG8_BAR; PG8_WAIT_L(0); PG8_MMA(1, 0, At, B0); PG8_BAR; PG8_SCHED;
            PG8_STAGE(PG8_SB(1, 1), b3 + hstep, voffB);
            PG8_WAIT_V(6); PG8_BAR; PG8_MMA(1, 1, At, B1); PG8_BAR;
            }
        }
        if constexpr (ALIGN_EPI) { if (wr == 0) PG8_BAR; }
        if constexpr (!Epi::AFTER_DRAIN) { E(acc, cur, wr, wc, fr, fq); S.done(cur); }
        if (!has_next) break;
#pragma unroll
        for (int a = 0; a < 2; ++a)
#pragma unroll
            for (int b = 0; b < 2; ++b)
#pragma unroll
                for (int m = 0; m < 4; ++m)
#pragma unroll
                    for (int n = 0; n < 2; ++n) acc[a][b][m][n] = (f32x4){0.f, 0.f, 0.f, 0.f};
        cur = nxt; cA = nA; cB = nB; ++ui;
        if constexpr (ALIGN_EPI) { if (wr == 1) PG8_BAR; }
    }
    PG8_WAIT_V(0);
    if constexpr (!ALIGN_EPI) { if (wr == 0) PG8_BAR; }
    PG8_BAR;
    if constexpr (Epi::AFTER_DRAIN) { E.fused(acc, cur, wr, wc, fr, fq, lds, wid, lane); S.done(cur); }
#undef PG8_SA
#undef PG8_SB
#undef PG8_STAGE
#undef PG8_LDA
#undef PG8_LDB
#undef PG8_MMA
#undef PG8_WAIT_V
#undef PG8_WAIT_L
#undef PG8_BAR
#undef PG8_SCHED
}
}
#define GAS __attribute__((address_space(1)))
#define LAS __attribute__((address_space(3)))
typedef unsigned short bf16;
typedef unsigned v4u __attribute__((ext_vector_type(4)));
typedef float f32x4 __attribute__((ext_vector_type(4)));
typedef short bf16x8 __attribute__((ext_vector_type(8)));
typedef GAS unsigned gu32;
typedef GAS unsigned long long gu64;
#define RLX_AGENT __ATOMIC_RELAXED, __HIP_MEMORY_SCOPE_AGENT
#define LDS_WAIT() asm volatile("s_waitcnt lgkmcnt(0)" ::: "memory")
#define VM_WAIT() asm volatile("s_waitcnt vmcnt(0)" ::: "memory")
__device__ __forceinline__ unsigned long long rt() { return __builtin_amdgcn_s_memrealtime(); }
__device__ __forceinline__ unsigned f2bf(float f) { unsigned u = __builtin_bit_cast(unsigned, f); return (u + 0x7fffu + ((u >> 16) & 1u)) >> 16; }
__device__ __forceinline__ unsigned pk2(float lo, float hi) { return f2bf(lo) | (f2bf(hi) << 16); }
typedef unsigned v2u __attribute__((ext_vector_type(2)));
#define XB_TMO      128
#define XB_XCNT(j)  (256  + 64 * (j))
#define XB_XSUB(j)  (1280 + 64 * (j))
#define XB_XGEN(j)  (2304 + 64 * (j))
#define XB_TOP      3328
#define XB_TOPGEN   3392
#define XCD_BAR_WORDS 3456
#define XB_SPIN_CAP (1u << 18)

__device__ __forceinline__ unsigned xb_ld(unsigned* p)              { return __hip_atomic_load(p, __ATOMIC_RELAXED, __HIP_MEMORY_SCOPE_AGENT); }
__device__ __forceinline__ unsigned xb_add(unsigned* p, unsigned v) { return __hip_atomic_fetch_add(p, v, __ATOMIC_RELAXED, __HIP_MEMORY_SCOPE_AGENT); }
__device__ __forceinline__ unsigned xb_xcc_id() { return (unsigned)__builtin_amdgcn_s_getreg((3 << 11) | 20) & 0xFu; }
#define XB_SPIN(cond, bar) do { unsigned _sp = 0; while (cond) { __builtin_amdgcn_s_sleep(1); \
    if ((++_sp & 255u) == 0u) { if (xb_ld(&(bar)[XB_TMO])) break; if (_sp > XB_SPIN_CAP) { atomicAdd(&(bar)[XB_TMO], 1u); break; } } } } while (0)

struct XcdBarrier {
    unsigned* bar; unsigned x;
    volatile LAS unsigned* st;
};

__device__ __forceinline__ XcdBarrier xcd_barrier_post(unsigned* bar, volatile LAS unsigned* st) {
    XcdBarrier b; b.bar = bar; b.x = xb_xcc_id(); b.st = st;
    if (threadIdx.x == 0) (void)xb_add(&bar[XB_XCNT(b.x)], 1u);
    return b;
}
__device__ __forceinline__ void xcd_barrier_complete(unsigned* bar, unsigned x, unsigned& nloc, unsigned& nx) {
    const unsigned G = gridDim.x * gridDim.y * gridDim.z;
    unsigned sum, cnt, mine, sp = 0u;
    for (;;) {
        sum = 0u; cnt = 0u; mine = 0u;
#pragma unroll
        for (unsigned j = 0; j < 16; ++j) { const unsigned c = xb_ld(&bar[XB_XCNT(j)]); sum += c; cnt += (c > 0u) ? 1u : 0u; mine = (j == x) ? c : mine; }
        if (sum == G) break;
        __builtin_amdgcn_s_sleep(1);
        if ((++sp & 255u) == 0u) { if (xb_ld(&bar[XB_TMO])) break; if (sp > XB_SPIN_CAP) { atomicAdd(&bar[XB_TMO], 1u); break; } }
    }
    nloc = mine > 0u ? mine : 1u; nx = cnt > 0u ? cnt : 1u;
}

__device__ __forceinline__ void xcd_barrier(const XcdBarrier& b) {
    asm volatile("s_waitcnt vmcnt(0)" ::: "memory");
    __syncthreads();
    if (threadIdx.x == 0) {
        unsigned* bar = b.bar;
        __builtin_amdgcn_s_waitcnt(0);
        unsigned nloc = b.st[0], nx = b.st[1];
        if (nloc == 0u) { xcd_barrier_complete(bar, b.x, nloc, nx); b.st[0] = nloc; b.st[1] = nx; }
        const unsigned old = xb_add(&bar[XB_XSUB(b.x)], 1u);
        const unsigned gen = old / nloc;
        if (old + 1u == (gen + 1u) * nloc) {
            __builtin_amdgcn_fence(__ATOMIC_RELEASE, "agent");
            asm volatile("s_waitcnt vmcnt(0)" ::: "memory");
            const unsigned og = xb_add(&bar[XB_TOP], 1u);
            const unsigned tg = og / nx;
            if (og + 1u == (tg + 1u) * nx) xb_add(&bar[XB_TOPGEN], 1u);
            else XB_SPIN(xb_ld(&bar[XB_TOPGEN]) == tg, bar);
            __builtin_amdgcn_fence(__ATOMIC_ACQUIRE, "agent");
            xb_add(&bar[XB_XGEN(b.x)], 1u);
            asm volatile("s_waitcnt vmcnt(0)" ::: "memory");
        } else {
            XB_SPIN(xb_ld(&bar[XB_XGEN(b.x)]) == gen, bar);
            __builtin_amdgcn_fence(__ATOMIC_ACQUIRE, "agent");
            asm volatile("s_waitcnt vmcnt(0)" ::: "memory");
        }
    }
    __syncthreads();
}
__device__ __forceinline__ void p0_transpose_item(const float* W, int K, int N, bf16* WT, int row_off, LAS float* scr, int item, int lane) {
    const int nblk = N / 32, kb = item / nblk, nb = item % nblk, k0 = 64 * kb, n0 = 32 * nb;
#pragma unroll 8
    for (int i = 0; i < 32; ++i) { const int kk = 2 * i + (lane >> 5); scr[kk * 33 + (lane & 31)] = W[(size_t)(k0 + kk) * N + n0 + (lane & 31)]; }
    LDS_WAIT(); asm volatile("" ::: "memory");
    const int c = lane & 7;
#pragma unroll
    for (int j = 0; j < 4; ++j) { const int n = (lane >> 3) + 8 * j; const LAS float* s = scr + (8 * c) * 33 + n;
        v4u o; o.x = pk2(s[0 * 33], s[1 * 33]); o.y = pk2(s[2 * 33], s[3 * 33]); o.z = pk2(s[4 * 33], s[5 * 33]); o.w = pk2(s[6 * 33], s[7 * 33]);
        *(GAS v4u*)(WT + (size_t)(row_off + n0 + n) * K + k0 + 8 * c) = o; }
    LDS_WAIT(); asm volatile("" ::: "memory");
}

constexpr int NWAVES = 8;
constexpr int NB = 8, T = 2048, M = NB * T, D = 1024, FF = 4096;
constexpr int NP0 = 3360, NP0P = 3584;
constexpr int NLOW = 1536, KLOW = 384;
constexpr int NQKV = 4608, DW = 512;
constexpr int C_R = 0, C_K = 512, C_V = 1024, C_WD = 1536, C_H = 1824, C_BG = 2336, C_CG = 2848;
constexpr float LN_EPS = 1e-5f, GN_EPS = 64e-5f, ALPHA = 1.4142135623730951f;
constexpr int N_IN = 25;
enum { I_X = 0, I_C, I_ADAW, I_ADAB, I_LNG, I_LNB, I_WIN, I_MU, I_W0, I_WUP, I_A0, I_AUP, I_GUP, I_KK, I_KA, I_RK, I_LNXG, I_LNXB, I_CONVW, I_WOUT0, I_WQKV, I_WOUT1, I_RELB, I_W1, I_W2 };

constexpr size_t MiB = 1u << 20;
constexpr size_t WS_CTL = 0, CTL_ZERO_BYTES = 1 * MiB;
constexpr size_t WS_MOD = 1 * MiB;
constexpr size_t WS_WIN = 2 * MiB, WS_WOUT0 = 9 * MiB, WS_W1A = 11 * MiB, WS_W2A = 19 * MiB, WS_WLOW = 27 * MiB;
constexpr size_t WS_WQKV = 2 * MiB, WS_WOUT1 = 11 * MiB, WS_W1B = 12 * MiB, WS_W2B = 20 * MiB;
constexpr size_t WS_AR = 29 * MiB;
constexpr size_t AR_U = WS_AR + 0 * MiB, AR_P0 = WS_AR + 32 * MiB, AR_EIG = WS_AR + 144 * MiB, AR_ACT = WS_AR + 192 * MiB, AR_Y = WS_AR + 192 * MiB;
constexpr size_t AR_A2 = WS_AR + 0 * MiB, AR_YGA = WS_AR + 32 * MiB;
constexpr size_t AR_U2 = WS_AR + 128 * MiB, AR_H = WS_AR + 0 * MiB, AR_YGB = WS_AR + 128 * MiB;
constexpr size_t AR_U3 = WS_AR + 0 * MiB, AR_QKV = WS_AR + 32 * MiB, AR_O = WS_AR + 176 * MiB, AR_YGC = WS_AR + 0 * MiB;
constexpr size_t WS_END = WS_AR + 224 * MiB;
static_assert(WS_END <= 256 * MiB, "d_ws map");
constexpr int CW_BAR = 4096;

constexpr int RING_OFF = 0, RING_BYTES = 131072;
constexpr int LDSCTL_OFF = RING_BYTES, MISC_OFF = LDSCTL_OFF + 320;
constexpr int LDS_BYTES = 147456;

struct Args { const float* in[N_IN]; float* out; unsigned char* ws; int ph_lo, ph_hi; };
struct Frame {
    LAS unsigned char* lds;
    volatile LAS unsigned* MISC;
    gu32* ctl;
    int tid, lane, wave;
    int vcu, G;
    float* out;
    unsigned char* ws;
};

__device__ __forceinline__ float bf_lo(unsigned u) { return __builtin_bit_cast(float, u << 16); }
__device__ __forceinline__ float bf_hi(unsigned u) { return __builtin_bit_cast(float, u & 0xffff0000u); }
template <int CTRL> __device__ __forceinline__ float dppf(float x) { return __builtin_bit_cast(float, __builtin_amdgcn_update_dpp(0, __builtin_bit_cast(int, x), CTRL, 0xF, 0xF, true)); }
__device__ __forceinline__ float red4(float x) { x += dppf<0xB1>(x); x += dppf<0x4E>(x); return x; }
__device__ __forceinline__ float red8(float x) { x = red4(x); x += dppf<0x141>(x); return x; }
__device__ __forceinline__ float red16(float x) { x = red8(x); x += dppf<0x140>(x); return x; }
__device__ __forceinline__ float wave_sum(float v) {
#pragma unroll
    for (int o = 1; o < 64; o <<= 1) v += __shfl_xor(v, o);
    return v;
}
__device__ __forceinline__ float wave_max(float v) {
#pragma unroll
    for (int o = 1; o < 64; o <<= 1) v = fmaxf(v, __shfl_xor(v, o));
    return v;
}
__device__ __forceinline__ void unpack8(const v4u w, float (&f)[8]) {
    f[0] = bf_lo(w.x); f[1] = bf_hi(w.x); f[2] = bf_lo(w.y); f[3] = bf_hi(w.y); f[4] = bf_lo(w.z); f[5] = bf_hi(w.z); f[6] = bf_lo(w.w); f[7] = bf_hi(w.w);
}
__device__ __forceinline__ v4u pack8(const float (&f)[8]) { v4u w; w.x = pk2(f[0], f[1]); w.y = pk2(f[2], f[3]); w.z = pk2(f[4], f[5]); w.w = pk2(f[6], f[7]); return w; }
__device__ __forceinline__ void ld8f(const float* p, float (&f)[8]) { const f32x4 a = *(const f32x4*)p, b = *(const f32x4*)(p + 4); f[0] = a[0]; f[1] = a[1]; f[2] = a[2]; f[3] = a[3]; f[4] = b[0]; f[5] = b[1]; f[6] = b[2]; f[7] = b[3]; }
__device__ __forceinline__ float sigmoidf_(float x) { return 1.f / (1.f + __expf(-x)); }

__device__ __forceinline__ void phase_mod(Frame& F, const Args& A) {
    LAS float* sc = (LAS float*)F.lds;
    LAS float* part = (LAS float*)(F.lds + 32768);
    const float* c = A.in[I_C];
    for (int i = F.tid; i < NB * D; i += NWAVES * 64) { const int b = i >> 10, k = i & 1023; const float cv = c[i]; sc[k * 8 + b] = cv / (1.f + __expf(-cv)); }
    __syncthreads();
    float* mod = (float*)(F.ws + WS_MOD);
    const int cg = F.lane & 15, kr = F.lane >> 4;
    for (int item = blockIdx.x; item < 192; item += F.G) {
        const int l = item / 96, cc = item % 96;
        const float* W = A.in[I_ADAW] + (size_t)l * D * 6144 + cc * 64 + cg * 4;
        f32x4 acc[8];
#pragma unroll
        for (int b = 0; b < 8; ++b) acc[b] = (f32x4){0.f, 0.f, 0.f, 0.f};
#pragma unroll 4
        for (int i = 0; i < 32; ++i) {
            const int k = F.wave * 128 + i * 4 + kr;
            const f32x4 w = *(const f32x4*)(W + (size_t)k * 6144);
            const f32x4 s0 = *(const LAS f32x4*)(sc + k * 8), s1 = *(const LAS f32x4*)(sc + k * 8 + 4);
#pragma unroll
            for (int b = 0; b < 4; ++b) { acc[b] += w * s0[b]; acc[4 + b] += w * s1[b]; }
        }
#pragma unroll
        for (int b = 0; b < 8; ++b)
#pragma unroll
            for (int j = 0; j < 4; ++j) { float v = acc[b][j]; v += __shfl_xor(v, 16); v += __shfl_xor(v, 32); acc[b][j] = v; }
        if (kr == 0) {
#pragma unroll
            for (int b = 0; b < 8; ++b) *(LAS f32x4*)(part + (F.wave * 8 + b) * 64 + cg * 4) = acc[b];
        }
        __syncthreads();
        { const int b = F.tid >> 6, col = F.tid & 63; float s = 0.f;
#pragma unroll
          for (int w = 0; w < 8; ++w) s += part[(w * 8 + b) * 64 + col];
          mod[((size_t)l * NB + b) * 6144 + cc * 64 + col] = s + A.in[I_ADAB][l * 6144 + cc * 64 + col]; }
        __syncthreads();
    }
}

__device__ __forceinline__ void modulate_row(const float* xrow, const float* sh, const float* sc, bf16* urow, int lane) {
#pragma unroll
    for (int j = 0; j < 4; ++j) { const int c4 = lane + 64 * j;
        const f32x4 x = ((const f32x4*)xrow)[c4], a = ((const f32x4*)sc)[c4], s = ((const f32x4*)sh)[c4];
        const f32x4 u = x * (a + 1.f) + s;
        v2u o; o.x = pk2(u[0], u[1]); o.y = pk2(u[2], u[3]); ((v2u*)urow)[c4] = o; }
}

__device__ __forceinline__ void phase_conv0(Frame& F, const Args& A) {
    LAS float* scr = (LAS float*)(F.lds + RING_OFF + F.wave * 16384);
    const int gw = F.vcu * NWAVES + F.wave, NGW = F.G * NWAVES;
    bf16* WIN = (bf16*)(F.ws + WS_WIN); bf16* WOUT = (bf16*)(F.ws + WS_WOUT0); bf16* W1 = (bf16*)(F.ws + WS_W1A); bf16* W2 = (bf16*)(F.ws + WS_W2A); bf16* WLOW = (bf16*)(F.ws + WS_WLOW);
    constexpr int I_IN = (D / 64) * (NP0 / 32), I_O = (D / 64) * (D / 32), I_1 = (D / 64) * (FF / 32), I_2 = (FF / 64) * (D / 32);
    constexpr int NITEMS = I_IN + I_O + I_1 + I_2;
    for (int it = gw; it < NITEMS; it += NGW) {
        int r = it;
        if (r < I_IN) { p0_transpose_item(A.in[I_WIN], D, NP0, WIN, 0, scr, r, F.lane); continue; } r -= I_IN;
        if (r < I_O) { p0_transpose_item(A.in[I_WOUT0], D, D, WOUT, 0, scr, r, F.lane); continue; } r -= I_O;
        if (r < I_1) { p0_transpose_item(A.in[I_W1], D, FF, W1, 0, scr, r, F.lane); continue; } r -= I_1;
        p0_transpose_item(A.in[I_W2], FF, D, W2, 0, scr, r, F.lane);
    }
    const int gt = F.vcu * NWAVES * 64 + F.tid, NT = F.G * NWAVES * 64;
    for (int i = gt; i < (NP0P - NP0) * D * 2 / 16; i += NT) ((v4u*)(WIN + (size_t)NP0 * D))[i] = (v4u){0u, 0u, 0u, 0u};
    for (int i = gt; i < NLOW * KLOW; i += NT) { const int n = i / KLOW, k = i % KLOW, blk = n >> 9, nn = n & 511; float v = 0.f;
        if (blk == 0) { if (k < 64) v = A.in[I_WUP][k * 512 + nn]; }
        else if (blk == 1) { if (k >= 64 && k < 128) v = A.in[I_AUP][(k - 64) * 512 + nn]; }
        else { if (k >= 128 && k < 288) v = A.in[I_GUP][(k - 128) * 512 + nn]; }
        WLOW[i] = (bf16)f2bf(v); }
    const float* mod = (const float*)(F.ws + WS_MOD);
    bf16* U = (bf16*)(F.ws + AR_U);
    for (int m = gw; m < M; m += NGW) { const float* mb = mod + (size_t)(m >> 11) * 6144; modulate_row(A.in[I_X] + (size_t)m * D, mb, mb + 1024, U + (size_t)m * D, F.lane); }
}

__device__ __forceinline__ void conv1_items(Frame& F, const Args& A) {
    LAS float* scr = (LAS float*)(F.lds + RING_OFF + F.wave * 16384);
    const int gw = F.vcu * NWAVES + F.wave, NGW = F.G * NWAVES;
    bf16* WQ = (bf16*)(F.ws + WS_WQKV); bf16* WO = (bf16*)(F.ws + WS_WOUT1); bf16* W1 = (bf16*)(F.ws + WS_W1B); bf16* W2 = (bf16*)(F.ws + WS_W2B);
    constexpr int I_Q = (D / 64) * (NQKV / 32), I_O = (DW / 64) * (D / 32), I_1 = (D / 64) * (FF / 32), I_2 = (FF / 64) * (D / 32);
    constexpr int NITEMS = I_Q + I_O + I_1 + I_2;
    for (int it = gw; it < NITEMS; it += NGW) {
        int r = it;
        if (r < I_Q) { p0_transpose_item(A.in[I_WQKV], D, NQKV, WQ, 0, scr, r, F.lane); continue; } r -= I_Q;
        if (r < I_O) { p0_transpose_item(A.in[I_WOUT1], DW, D, WO, 0, scr, r, F.lane); continue; } r -= I_O;
        if (r < I_1) { p0_transpose_item(A.in[I_W1] + (size_t)D * FF, D, FF, W1, 0, scr, r, F.lane); continue; } r -= I_1;
        p0_transpose_item(A.in[I_W2] + (size_t)FF * D, FF, D, W2, 0, scr, r, F.lane);
    }
}

__device__ __forceinline__ void phase_act(Frame& F, const Args& A) {
    const int gw = F.vcu * NWAVES + F.wave, NGW = F.G * NWAVES;
    const bf16* P0 = (const bf16*)(F.ws + AR_P0); bf16* ACT = (bf16*)(F.ws + AR_ACT);
    const int lane = F.lane, j0 = 8 * lane;
    float mu[8];
    if (lane < 36) ld8f(A.in[I_MU] + C_WD + j0, mu);
    else {
#pragma unroll
        for (int e = 0; e < 8; ++e) mu[e] = 0.f;
    }
    for (int m = gw; m < M; m += NGW) {
        if (lane < 36) {
            const int t = m & (T - 1);
            float cur[8], prv[8], o[8];
            unpack8(*(const v4u*)(P0 + (size_t)m * NP0P + C_WD + j0), cur);
            if (t > 0) unpack8(*(const v4u*)(P0 + (size_t)(m - 1) * NP0P + C_WD + j0), prv);
            else {
#pragma unroll
                for (int e = 0; e < 8; ++e) prv[e] = 0.f;
            }
#pragma unroll
            for (int e = 0; e < 8; ++e) { const float x = cur[e] + mu[e] * (prv[e] - cur[e]);
                o[e] = (j0 < 64) ? (1.f - 2.f / (__expf(2.f * x) + 1.f)) : (j0 < 128) ? x : sigmoidf_(x); }
            *(v4u*)(ACT + (size_t)m * KLOW + j0) = pack8(o);
        } else if (lane < 48) {
            *(v4u*)(ACT + (size_t)m * KLOW + j0) = (v4u){0u, 0u, 0u, 0u};
        }
    }
}

constexpr int SC_CH = 32, SC_REC = 5 * 64 * 4, SC_BUF = SC_CH * (SC_REC + 64);
__device__ __forceinline__ void scan_produce(Frame& F, const Args& A, int b, int h, int q, int chunk, LAS unsigned char* buf,
                                             const float (&mu_r)[4], const float (&mu_k)[4], const float (&kkc)[4], const float (&kac)[4], const float (&mu_v)[2]) {
    const bf16* P0 = (const bf16*)(F.ws + AR_P0); const bf16* EIG = (const bf16*)(F.ws + AR_EIG);
    const int pw = F.wave - 4, lane = F.lane, seg = lane & 15, kcol = h * 64 + seg * 4;
#pragma unroll
    for (int pass = 0; pass < 2; ++pass) {
        const int tl = pass * 16 + pw * 4 + (lane >> 4), t = chunk * SC_CH + tl; const size_t m = (size_t)b * T + t;
        const v2u rc = *(const v2u*)(P0 + m * NP0P + C_R + kcol), kc = *(const v2u*)(P0 + m * NP0P + C_K + kcol);
        v2u rp = (v2u){0u, 0u}, kp = (v2u){0u, 0u};
        if (t > 0) { rp = *(const v2u*)(P0 + (m - 1) * NP0P + C_R + kcol); kp = *(const v2u*)(P0 + (m - 1) * NP0P + C_K + kcol); }
        const v2u ev = *(const v2u*)(EIG + m * NLOW + kcol), iv = *(const v2u*)(EIG + m * NLOW + 512 + kcol);
        float r4[4], k4[4], e4[4], ic[4], cr[4], pr[4], ck[4], pk[4];
        cr[0] = bf_lo(rc.x); cr[1] = bf_hi(rc.x); cr[2] = bf_lo(rc.y); cr[3] = bf_hi(rc.y);
        pr[0] = bf_lo(rp.x); pr[1] = bf_hi(rp.x); pr[2] = bf_lo(rp.y); pr[3] = bf_hi(rp.y);
        ck[0] = bf_lo(kc.x); ck[1] = bf_hi(kc.x); ck[2] = bf_lo(kc.y); ck[3] = bf_hi(kc.y);
        pk[0] = bf_lo(kp.x); pk[1] = bf_hi(kp.x); pk[2] = bf_lo(kp.y); pk[3] = bf_hi(kp.y);
        e4[0] = bf_lo(ev.x); e4[1] = bf_hi(ev.x); e4[2] = bf_lo(ev.y); e4[3] = bf_hi(ev.y);
        ic[0] = bf_lo(iv.x); ic[1] = bf_hi(iv.x); ic[2] = bf_lo(iv.y); ic[3] = bf_hi(iv.y);
        float kr[4], n2 = 0.f;
#pragma unroll
        for (int e = 0; e < 4; ++e) { r4[e] = cr[e] + mu_r[e] * (pr[e] - cr[e]); k4[e] = ck[e] + mu_k[e] * (pk[e] - ck[e]); kr[e] = k4[e] * kkc[e]; n2 += kr[e] * kr[e]; }
        n2 = red16(n2);
        const float inv = 1.f / fmaxf(sqrtf(n2), 1e-12f);
        f32x4 va, vw, vb, vk, vr;
#pragma unroll
        for (int e = 0; e < 4; ++e) { const float kk = kr[e] * inv; va[e] = -kk; vw[e] = __expf(-e4[e]); vb[e] = kk * ic[e]; vk[e] = k4[e] * (1.f + (ic[e] - 1.f) * kac[e]); vr[e] = r4[e]; }
        LAS float* rec = (LAS float*)(buf + tl * SC_REC) + seg * 4;
        *(LAS f32x4*)(rec) = va; *(LAS f32x4*)(rec + 64) = vw; *(LAS f32x4*)(rec + 128) = vb; *(LAS f32x4*)(rec + 192) = vk; *(LAS f32x4*)(rec + 256) = vr;
    }
    {
        const int ptid = pw * 64 + lane, tl = ptid >> 3, j = (ptid & 7) * 2, t = chunk * SC_CH + tl; const size_t m = (size_t)b * T + t;
        const int col = C_V + h * 64 + q * 16 + j;
        const unsigned vc = *(const unsigned*)(P0 + m * NP0P + col); unsigned vp = 0u;
        if (t > 0) vp = *(const unsigned*)(P0 + (m - 1) * NP0P + col);
        const float c0 = bf_lo(vc), c1 = bf_hi(vc), p0 = bf_lo(vp), p1 = bf_hi(vp);
        LAS float* vb = (LAS float*)(buf + SC_CH * SC_REC) + tl * 16 + j;
        vb[0] = c0 + mu_v[0] * (p0 - c0); vb[1] = c1 + mu_v[1] * (p1 - c1);
    }
}
__device__ __forceinline__ void phase_scan(Frame& F, const Args& A) {
    float* Y = (float*)(F.ws + AR_Y);
    const int lane = F.lane, seg = lane & 15, rg = lane >> 4;
    for (int item = F.vcu; item < NB * 8 * 4; item += F.G) {
        const int bh = item >> 2, q = item & 3, b = bh >> 3, h = bh & 7;
        float mu_r[4], mu_k[4], kkc[4], kac[4], mu_v[2];
        { const int kcol = h * 64 + seg * 4;
#pragma unroll
          for (int e = 0; e < 4; ++e) { mu_r[e] = A.in[I_MU][C_R + kcol + e]; mu_k[e] = A.in[I_MU][C_K + kcol + e]; kkc[e] = A.in[I_KK][kcol + e]; kac[e] = A.in[I_KA][kcol + e]; }
          const int ptid = (F.wave & 3) * 64 + lane, j = (ptid & 7) * 2; mu_v[0] = A.in[I_MU][C_V + h * 64 + q * 16 + j]; mu_v[1] = A.in[I_MU][C_V + h * 64 + q * 16 + j + 1]; }
        LAS unsigned char* buf0 = F.lds, * buf1 = F.lds + SC_BUF;
        if (F.wave >= 4) scan_produce(F, A, b, h, q, 0, buf0, mu_r, mu_k, kkc, kac, mu_v);
        __syncthreads();
        float S0 = 0.f, S1 = 0.f, S2 = 0.f, S3 = 0.f;
        const int row = 4 * F.wave + rg;
        for (int c = 0; c < T / SC_CH; ++c) {
            LAS unsigned char* cur = (c & 1) ? buf1 : buf0; LAS unsigned char* nxt = (c & 1) ? buf0 : buf1;
            if (F.wave >= 4) { if (c + 1 < T / SC_CH) scan_produce(F, A, b, h, q, c + 1, nxt, mu_r, mu_k, kkc, kac, mu_v); }
            else {
                const LAS float* vbase = (const LAS float*)(cur + SC_CH * SC_REC) + row;
                float* yp = Y + ((size_t)b * T + c * SC_CH) * DW + h * 64 + q * 16 + row;
#pragma unroll 4
                for (int tl = 0; tl < SC_CH; ++tl) {
                    const LAS float* rec = (const LAS float*)(cur + tl * SC_REC) + seg * 4;
                    const f32x4 a = *(const LAS f32x4*)(rec), w = *(const LAS f32x4*)(rec + 64), bb = *(const LAS f32x4*)(rec + 128), kk = *(const LAS f32x4*)(rec + 192), r = *(const LAS f32x4*)(rec + 256);
                    const float vv = vbase[tl * 16];
                    float sa = (S0 * a[0] + S1 * a[1]) + (S2 * a[2] + S3 * a[3]);
                    sa = red16(sa);
                    S0 = S0 * w[0] + (sa * bb[0] + vv * kk[0]);
                    S1 = S1 * w[1] + (sa * bb[1] + vv * kk[1]);
                    S2 = S2 * w[2] + (sa * bb[2] + vv * kk[2]);
                    S3 = S3 * w[3] + (sa * bb[3] + vv * kk[3]);
                    float y = (S0 * r[0] + S1 * r[1]) + (S2 * r[2] + S3 * r[3]);
                    y = red16(y);
                    if (seg == 0) yp[(size_t)tl * DW] = y;
                }
            }
            __syncthreads();
        }
    }
}

__device__ __forceinline__ void phase_post(Frame& F, const Args& A) {
    const int gw = F.vcu * NWAVES + F.wave, NGW = F.G * NWAVES, lane = F.lane, c0 = lane * 8;
    const bf16* P0 = (const bf16*)(F.ws + AR_P0); const bf16* EIG = (const bf16*)(F.ws + AR_EIG); const float* Y = (const float*)(F.ws + AR_Y); bf16* A2 = (bf16*)(F.ws + AR_A2);
    float mu_r[8], mu_k[8], mu_v[8], ka[8], rk[8], lg[8], lb[8], cw0[8], cw1[8], cw2[8];
    ld8f(A.in[I_MU] + C_R + c0, mu_r); ld8f(A.in[I_MU] + C_K + c0, mu_k); ld8f(A.in[I_MU] + C_V + c0, mu_v);
    ld8f(A.in[I_KA] + c0, ka); ld8f(A.in[I_RK] + c0, rk); ld8f(A.in[I_LNXG] + c0, lg); ld8f(A.in[I_LNXB] + c0, lb);
    ld8f(A.in[I_CONVW] + c0, cw0); ld8f(A.in[I_CONVW] + 512 + c0, cw1); ld8f(A.in[I_CONVW] + 1024 + c0, cw2);
    for (int m = gw; m < M; m += NGW) {
        const int t = m & (T - 1);
        const bf16* p = P0 + (size_t)m * NP0P; const bf16* pm1 = p - NP0P; const bf16* pm2 = p - 2 * NP0P;
        float rc[8], rp[8], kc[8], kp[8], vc[8], vp[8], ic[8], gt[8], y[8];
        unpack8(*(const v4u*)(p + C_R + c0), rc); unpack8(*(const v4u*)(p + C_K + c0), kc); unpack8(*(const v4u*)(p + C_V + c0), vc);
        if (t > 0) { unpack8(*(const v4u*)(pm1 + C_R + c0), rp); unpack8(*(const v4u*)(pm1 + C_K + c0), kp); unpack8(*(const v4u*)(pm1 + C_V + c0), vp); }
        else {
#pragma unroll
            for (int e = 0; e < 8; ++e) { rp[e] = 0.f; kp[e] = 0.f; vp[e] = 0.f; }
        }
        unpack8(*(const v4u*)(EIG + (size_t)m * NLOW + 512 + c0), ic); unpack8(*(const v4u*)(EIG + (size_t)m * NLOW + 1024 + c0), gt);
        ld8f(Y + (size_t)m * DW + c0, y);
        float bon = 0.f, s = 0.f, vs[8];
#pragma unroll
        for (int e = 0; e < 8; ++e) { const float r = rc[e] + mu_r[e] * (rp[e] - rc[e]), k = kc[e] + mu_k[e] * (kp[e] - kc[e]); vs[e] = vc[e] + mu_v[e] * (vp[e] - vc[e]);
            const float kh = k * (1.f + (ic[e] - 1.f) * ka[e]); bon += r * kh * rk[e]; s += y[e]; }
        bon = red8(bon); s = red8(s);
        const float mean = s * (1.f / 64.f); float q = 0.f;
#pragma unroll
        for (int e = 0; e < 8; ++e) { y[e] -= mean; q += y[e] * y[e]; }
        q = red8(q);
        const float rstd = 1.f / sqrtf(q * (1.f / 64.f) + GN_EPS);
        float o[8];
#pragma unroll
        for (int e = 0; e < 8; ++e) o[e] = (y[e] * rstd * lg[e] + lb[e] + bon * vs[e]) * gt[e];
        *(v4u*)(A2 + (size_t)m * D + c0) = pack8(o);
        float h0[8], g0[8], h1[8], g1[8], h2[8], g2[8], bg[8];
        unpack8(*(const v4u*)(p + C_H + c0), h0); unpack8(*(const v4u*)(p + C_CG + c0), g0); unpack8(*(const v4u*)(p + C_BG + c0), bg);
        if (t > 0) { unpack8(*(const v4u*)(pm1 + C_H + c0), h1); unpack8(*(const v4u*)(pm1 + C_CG + c0), g1); }
        else {
#pragma unroll
            for (int e = 0; e < 8; ++e) { h1[e] = 0.f; g1[e] = 0.f; }
        }
        if (t > 1) { unpack8(*(const v4u*)(pm2 + C_H + c0), h2); unpack8(*(const v4u*)(pm2 + C_CG + c0), g2); }
        else {
#pragma unroll
            for (int e = 0; e < 8; ++e) { h2[e] = 0.f; g2[e] = 0.f; }
        }
#pragma unroll
        for (int e = 0; e < 8; ++e) o[e] = bg[e] * (cw0[e] * (g2[e] * h2[e]) + cw1[e] * (g1[e] * h1[e]) + cw2[e] * (g0[e] * h0[e]));
        *(v4u*)(A2 + (size_t)m * D + 512 + c0) = pack8(o);
    }
}

__device__ __forceinline__ void phase_ln(Frame& F, const float* xin, const float* yg, const float* gmod  , const float* lng, const float* lnb,
                                         float* xout, bf16* U, const float* shmod, const float* scmod) {
    const int gw = F.vcu * NWAVES + F.wave, NGW = F.G * NWAVES, lane = F.lane;
    for (int m = gw; m < M; m += NGW) {
        const int b = m >> 11;
        const f32x4* xr = (const f32x4*)(xin + (size_t)m * D); const f32x4* yr = (const f32x4*)(yg + (size_t)m * D); const f32x4* gr = (const f32x4*)(gmod + (size_t)b * 6144);
        f32x4 v[4]; float s = 0.f;
#pragma unroll
        for (int j = 0; j < 4; ++j) { const int c4 = lane + 64 * j; v[j] = xr[c4] * ALPHA + (gr[c4] + 1.f) * yr[c4]; s += (v[j][0] + v[j][1]) + (v[j][2] + v[j][3]); }
        const float mean = wave_sum(s) * (1.f / D); float s2 = 0.f;
#pragma unroll
        for (int j = 0; j < 4; ++j) { v[j] = v[j] - mean; s2 += (v[j][0] * v[j][0] + v[j][1] * v[j][1]) + (v[j][2] * v[j][2] + v[j][3] * v[j][3]); }
        const float rstd = 1.f / sqrtf(wave_sum(s2) * (1.f / D) + LN_EPS);
#pragma unroll
        for (int j = 0; j < 4; ++j) { const int c4 = lane + 64 * j;
            const f32x4 o = v[j] * rstd * ((const f32x4*)lng)[c4] + ((const f32x4*)lnb)[c4];
            ((f32x4*)(xout + (size_t)m * D))[c4] = o;
            if (U) { const f32x4 u = o * (((const f32x4*)(scmod + (size_t)b * 6144))[c4] + 1.f) + ((const f32x4*)(shmod + (size_t)b * 6144))[c4];
                v2u w; w.x = pk2(u[0], u[1]); w.y = pk2(u[2], u[3]); ((v2u*)(U + (size_t)m * D))[c4] = w; } }
    }
}

__device__ __forceinline__ int t5_bucket(int dist) {
    if (dist < 16) return dist;
    const float logd = __logf((float)dist / 16.f) / 4.852030263919617f;
    const int large = 16 + (int)(logd * 16.f);
    return large < 31 ? large : 31;
}
__device__ __forceinline__ void phase_attn_simple(Frame& F, const Args& A) {
    LAS float* biasT = (LAS float*)F.lds;
    for (int i = F.tid; i < 3 * 8 * 129; i += NWAVES * 64) { const int g = i / (8 * 129), h = (i / 129) & 7, j = i % 129; const int dil = g == 0 ? 1 : g == 1 ? 4 : 16;
        biasT[i] = A.in[I_RELB][t5_bucket(j * dil) * 24 + g * 8 + h]; }
    __syncthreads();
    const bf16* QKV = (const bf16*)(F.ws + AR_QKV); bf16* O = (bf16*)(F.ws + AR_O);
    const int gw = F.vcu * NWAVES + F.wave, NGW = F.G * NWAVES, lane = F.lane;
    for (int item = gw; item < M * 8; item += NGW) {
        const int h = item / M, m = item % M, t = m & (T - 1);
        float sc[3][3]; float mx = -1e30f;
#pragma unroll
        for (int g = 0; g < 3; ++g) {
            const int dil = g == 0 ? 1 : g == 1 ? 4 : 16, ms = t / dil;
            float qf[64];
            { const v4u* qp = (const v4u*)(QKV + (size_t)m * NQKV + g * 1536 + h * 64);
#pragma unroll
              for (int i = 0; i < 8; ++i) { float f[8]; unpack8(qp[i], f);
#pragma unroll
                  for (int e = 0; e < 8; ++e) qf[i * 8 + e] = f[e]; } }
#pragma unroll
            for (int jc = 0; jc < 3; ++jc) {
                const int j = jc < 2 ? lane + 64 * jc : 128;
                const bool valid = (jc < 2 || lane == 0) && (ms - j >= 0);
                float s = -1e30f;
                if (valid) {
                    const v4u* kp = (const v4u*)(QKV + (size_t)(m - j * dil) * NQKV + g * 1536 + 512 + h * 64);
                    float d = 0.f;
#pragma unroll
                    for (int i = 0; i < 8; ++i) { float f[8]; unpack8(kp[i], f);
#pragma unroll
                        for (int e = 0; e < 8; ++e) d += qf[i * 8 + e] * f[e]; }
                    s = d * 0.125f + biasT[(g * 8 + h) * 129 + j];
                }
                sc[g][jc] = s; mx = fmaxf(mx, s);
            }
        }
        mx = wave_max(mx);
        float sum = 0.f;
#pragma unroll
        for (int g = 0; g < 3; ++g)
#pragma unroll
            for (int jc = 0; jc < 3; ++jc) { const float p = sc[g][jc] > -1e29f ? __expf(sc[g][jc] - mx) : 0.f; sc[g][jc] = p; sum += p; }
        sum = wave_sum(sum);
        float acc = 0.f;
#pragma unroll
        for (int g = 0; g < 3; ++g) {
            const int dil = g == 0 ? 1 : g == 1 ? 4 : 16, ms = t / dil;
            const bf16* vb = QKV + (size_t)m * NQKV + g * 1536 + 1024 + h * 64 + lane;
#pragma unroll
            for (int jc = 0; jc < 2; ++jc) {
                const int nj = (ms - 64 * jc + 1) < 64 ? (ms - 64 * jc + 1) : 64;
                for (int jj = 0; jj < nj; ++jj) { const float p = __builtin_bit_cast(float, __builtin_amdgcn_readlane(__builtin_bit_cast(int, sc[g][jc]), jj));
                    const int j = 64 * jc + jj; acc += p * bf_lo((unsigned)vb[-(long)j * dil * NQKV]); }
            }
            if (ms >= 128) { const float p = __builtin_bit_cast(float, __builtin_amdgcn_readlane(__builtin_bit_cast(int, sc[g][2]), 0)); acc += p * bf_lo((unsigned)vb[-(long)128 * dil * NQKV]); }
        }
        O[(size_t)m * DW + h * 64 + lane] = (bf16)f2bf(acc / sum);
    }
}

#ifndef MK_SINGLE
#define MK_SINGLE 1
#endif
constexpr int N_PHASES = 19;
enum { PH_MOD = 0, PH_CONV0, PH_G_IN, PH_ACT, PH_G_LOW, PH_SCAN, PH_POST, PH_G_OUT0, PH_LN1, PH_G_UP0, PH_G_DN0, PH_LN2, PH_G_QKV, PH_ATTN, PH_G_OUT1, PH_LN3, PH_G_UP1, PH_G_DN1, PH_LN4 };

__global__ void __launch_bounds__(NWAVES * 64, 2) fwd_kernel(Args args) {
    extern __shared__ __attribute__((aligned(16))) unsigned char lds[];
    Frame F;
    F.lds = (LAS unsigned char*)lds;
    F.MISC = (volatile LAS unsigned*)(F.lds + MISC_OFF);
    F.tid = threadIdx.x; F.lane = F.tid & 63; F.wave = __builtin_amdgcn_readfirstlane(F.tid >> 6);
    F.G = gridDim.x; { const int bx = blockIdx.x; F.vcu = (F.G % 8 == 0) ? (bx % 8) * (F.G / 8) + bx / 8 : bx; }
    F.ws = args.ws; F.out = args.out; F.ctl = (gu32*)(args.ws + WS_CTL);
    for (int u = F.tid; u < (LDS_BYTES - LDSCTL_OFF) / 4; u += NWAVES * 64) ((LAS unsigned*)(F.lds + LDSCTL_OFF))[u] = 0u;
    __syncthreads();
    const int lo = args.ph_lo, hi = args.ph_hi;
    XcdBarrier bar; bar.bar = (unsigned*)(F.ctl + CW_BAR); bar.x = 0; bar.st = nullptr;
    if (hi - lo > 1) bar = xcd_barrier_post((unsigned*)(F.ctl + CW_BAR), F.MISC + 8);

    unsigned char* ws = args.ws;
    float* mod = (float*)(ws + WS_MOD);
#ifndef PH_MASK
#define PH_MASK 0x7ffff
#endif
#define PHON(k) (((PH_MASK) >> (k)) & 1)
#define IN(k) (PHON(k) && lo <= (k) && (k) < hi)
#define PHASE_BEGIN() do { int t_ = threadIdx.x; asm volatile("" : "+v"(t_)); F.tid = t_; F.lane = t_ & 63; F.wave = __builtin_amdgcn_readfirstlane(t_ >> 6); \
        unsigned long long wi_ = (unsigned long long)args.ws; asm volatile("" : "+s"(wi_)); unsigned char* w_ = (unsigned char*)(GAS unsigned char*)wi_; ws = w_; F.ws = w_; mod = (float*)(w_ + WS_MOD); } while (0)
#define PHASE_END(k) do { if ((k) + 1 < hi) xcd_barrier(bar); } while (0)
#define GEMM_PHASE(EPI, Aoff, Boff, N_, K_, ...) do { pg8::Gemm g{(const bf16*)(ws + (Aoff)), (const bf16*)(ws + (Boff)), M, (N_), (K_)}; \
        pg8::StaticOrder S; S.init(M, (N_), F.G, (int)blockIdx.x); EPI E{__VA_ARGS__}; \
        pg8::gemm_phase<EPI, pg8::StaticOrder, true, true>(F.lds + RING_OFF, g, S, E); } while (0)

    if (IN(PH_MOD))    { PHASE_BEGIN(); phase_mod(F, args); PHASE_END(PH_MOD); }
    if (IN(PH_CONV0))  { PHASE_BEGIN(); phase_conv0(F, args); PHASE_END(PH_CONV0); }
    if (IN(PH_G_IN))   { PHASE_BEGIN(); GEMM_PHASE(pg8::EpiBf16<0>, AR_U, WS_WIN, NP0P, D, (bf16*)(ws + AR_P0), NP0P); PHASE_END(PH_G_IN); }
    if (IN(PH_ACT))    { PHASE_BEGIN(); phase_act(F, args); PHASE_END(PH_ACT); }
    if (IN(PH_G_LOW))  { PHASE_BEGIN(); GEMM_PHASE(pg8::EpiLow, AR_ACT, WS_WLOW, NLOW, KLOW, (bf16*)(ws + AR_EIG), NLOW, args.in[I_W0], args.in[I_A0]); PHASE_END(PH_G_LOW); }
    if (IN(PH_SCAN))   { PHASE_BEGIN(); phase_scan(F, args); PHASE_END(PH_SCAN); }
    if (IN(PH_POST))   { PHASE_BEGIN(); phase_post(F, args); PHASE_END(PH_POST); }
    if (IN(PH_G_OUT0)) { PHASE_BEGIN(); GEMM_PHASE(pg8::EpiF32, AR_A2, WS_WOUT0, D, D, (float*)(ws + AR_YGA), D); PHASE_END(PH_G_OUT0); }
    if (IN(PH_LN1))    { PHASE_BEGIN(); phase_ln(F, args.in[I_X], (const float*)(ws + AR_YGA), mod + 2048, args.in[I_LNG], args.in[I_LNB], F.out, (bf16*)(ws + AR_U2), mod + 3072, mod + 4096); PHASE_END(PH_LN1); }
    if (IN(PH_G_UP0))  { PHASE_BEGIN(); GEMM_PHASE(pg8::EpiBf16<1>, AR_U2, WS_W1A, FF, D, (bf16*)(ws + AR_H), FF); PHASE_END(PH_G_UP0); }
    if (IN(PH_G_DN0))  { PHASE_BEGIN(); GEMM_PHASE(pg8::EpiF32, AR_H, WS_W2A, D, FF, (float*)(ws + AR_YGB), D); PHASE_END(PH_G_DN0); }
    if (IN(PH_LN2))    { PHASE_BEGIN(); conv1_items(F, args);
                         phase_ln(F, F.out, (const float*)(ws + AR_YGB), mod + 5120, args.in[I_LNG] + 1024, args.in[I_LNB] + 1024, F.out, (bf16*)(ws + AR_U3), mod + NB * 6144, mod + NB * 6144 + 1024); PHASE_END(PH_LN2); }
    if (IN(PH_G_QKV))  { PHASE_BEGIN(); GEMM_PHASE(pg8::EpiBf16<0>, AR_U3, WS_WQKV, NQKV, D, (bf16*)(ws + AR_QKV), NQKV); PHASE_END(PH_G_QKV); }
    if (IN(PH_ATTN))   { PHASE_BEGIN(); phase_attn_simple(F, args); PHASE_END(PH_ATTN); }
    if (IN(PH_G_OUT1)) { PHASE_BEGIN(); GEMM_PHASE(pg8::EpiF32, AR_O, WS_WOUT1, D, DW, (float*)(ws + AR_YGC), D); PHASE_END(PH_G_OUT1); }
    if (IN(PH_LN3))    { PHASE_BEGIN(); phase_ln(F, F.out, (const float*)(ws + AR_YGC), mod + NB * 6144 + 2048, args.in[I_LNG] + 2048, args.in[I_LNB] + 2048, F.out, (bf16*)(ws + AR_U2), mod + NB * 6144 + 3072, mod + NB * 6144 + 4096); PHASE_END(PH_LN3); }
    if (IN(PH_G_UP1))  { PHASE_BEGIN(); GEMM_PHASE(pg8::EpiBf16<1>, AR_U2, WS_W1B, FF, D, (bf16*)(ws + AR_H), FF); PHASE_END(PH_G_UP1); }
    if (IN(PH_G_DN1))  { PHASE_BEGIN(); GEMM_PHASE(pg8::EpiF32, AR_H, WS_W2B, D, FF, (float*)(ws + AR_YGB), D); PHASE_END(PH_G_DN1); }
    if (IN(PH_LN4))    { PHASE_BEGIN(); phase_ln(F, F.out, (const float*)(ws + AR_YGB), mod + NB * 6144 + 5120, args.in[I_LNG] + 3072, args.in[I_LNB] + 3072, F.out, (bf16*)nullptr, mod, mod); }
}

extern "C" void kernel_launch(void* const* d_in, const int* in_sizes, int n_in, void* d_out, int out_size, void* d_ws, size_t ws_size, hipStream_t stream) {
    static int grid = 0;
    if (grid == 0) {
        if (n_in != N_IN || in_sizes[0] != M * D || out_size != M * D || ws_size < WS_END) {
            fprintf(stderr, "kernel_launch: unexpected problem: n_in %d in0 %d out %d ws %zu (need %zu); nothing launched\n", n_in, n_in > 0 ? in_sizes[0] : -1, out_size, ws_size, (size_t)WS_END); grid = -1; return; }
        int dev = 0, cus = 0, per_cu = 0;
        if (hipGetDevice(&dev) != hipSuccess || hipDeviceGetAttribute(&cus, hipDeviceAttributeMultiprocessorCount, dev) != hipSuccess) { fprintf(stderr, "kernel_launch: device query failed\n"); grid = -1; return; }
        if (hipFuncSetAttribute((const void*)fwd_kernel, hipFuncAttributeMaxDynamicSharedMemorySize, LDS_BYTES) != hipSuccess) { fprintf(stderr, "kernel_launch: hipFuncSetAttribute failed\n"); grid = -1; return; }
        if (hipOccupancyMaxActiveBlocksPerMultiprocessor(&per_cu, (const void*)fwd_kernel, NWAVES * 64, LDS_BYTES) != hipSuccess || per_cu < 1) { fprintf(stderr, "kernel_launch: occupancy query says %d blocks per CU\n", per_cu); per_cu = 1; }
        (void)hipGetLastError();
        grid = cus * (per_cu < 1 ? 1 : per_cu);
        if (grid > cus) grid = cus;
    }
    if (grid < 0) return;
    (void)hipMemsetAsync((char*)d_ws + WS_CTL, 0, CTL_ZERO_BYTES, stream);
    Args a{};
    for (int i = 0; i < N_IN; ++i) a.in[i] = (const float*)d_in[i];
    a.out = (float*)d_out; a.ws = (unsigned char*)d_ws;
#if MK_SINGLE
    a.ph_lo = 0; a.ph_hi = N_PHASES;
    void* kargs[] = {&a};
    hipError_t e = hipLaunchCooperativeKernel((const void*)fwd_kernel, dim3(grid), dim3(NWAVES * 64), kargs, LDS_BYTES, stream);
    if (e != hipSuccess) fprintf(stderr, "kernel_launch: cooperative launch failed: %s (grid %d)\n", hipGetErrorString(e), grid);
#else
    for (int ph = 0; ph < N_PHASES; ++ph) {
        a.ph_lo = ph; a.ph_hi = ph + 1;
        hipLaunchKernelGGL(fwd_kernel, dim3(grid), dim3(NWAVES * 64), LDS_BYTES, stream, a);
    }
#endif
}
```

```cpp
#include <hip/hip_runtime.h>
#include <cstdio>
#include <cstdint>
#define MK_SINGLE 1
namespace pg8 {
#define PG8_LAS __attribute__((address_space(3)))
typedef unsigned short bf16_t;
typedef short bf16x8 __attribute__((ext_vector_type(8)));
typedef float f32x4 __attribute__((ext_vector_type(4)));
typedef unsigned u32x4 __attribute__((ext_vector_type(4)));
constexpr int BM = 256, BK = 64, HALF = 128, HTB = HALF * BK * 2  , STAGE_BYTES = 8 * HTB, NXCD = 8, WGM = 8;

__host__ __device__ __forceinline__ int lds_byte(int r, int c) { const int st = (r >> 4) * 2 + (c >> 5), rr = r & 15, cc = c & 31, ob = rr * 64 + cc * 2; return st * 1024 + (ob ^ (((ob >> 9) & 1) << 5)); }
__host__ __device__ __forceinline__ void stage_rc(int b, int& R, int& C) { const int st = b / 1024, sb = b % 1024, swz = sb ^ (((sb >> 9) & 1) << 5); R = (st >> 1) * 16 + swz / 64; C = (st & 1) * 32 + (swz % 64) / 2; }
__host__ __device__ __forceinline__ int perm32(int rho) { const int n = rho >> 4, i = rho & 15; return 8 * (i >> 2) + 4 * n + (i & 3); }

struct Unit { int pm, pn; };
struct Gemm { const bf16_t* A; const bf16_t* Bt; int M, N, K; };

struct StaticOrder {
    int nM, nN, nwg, G, c;
    __host__ __device__ void init(int M, int N, int G_, int c_) { nM = M / BM; nN = N / BM; nwg = nM * nN; G = G_; c = c_; }
    __host__ __device__ bool next(int i, Unit& u) const {
        const long L = (long)i * G + c; if (L >= nwg) return false;
        int wgid = (int)L; { const int q = nwg / NXCD, r = nwg % NXCD, xcd = wgid % NXCD, off = wgid / NXCD; wgid = (xcd < r ? xcd * (q + 1) : r * (q + 1) + (xcd - r) * q) + off; }
        const int nig = WGM * nN, gid = wgid / nig, fm = gid * WGM, gsz = (nM - fm) < WGM ? (nM - fm) : WGM;
        u.pm = fm + ((wgid % nig) % gsz); u.pn = (wgid % nig) / gsz; return true;
    }
    __device__ __forceinline__ void a_ready(const Unit&) const {}
    __device__ __forceinline__ void done(const Unit&) const {}
};


__device__ __forceinline__ unsigned cvt_pk_bf16(float lo, float hi) { unsigned r; asm volatile("v_cvt_pk_bf16_f32 %0, %1, %2" : "=v"(r) : "v"(lo), "v"(hi)); return r; }

template <int ACT> struct EpiBf16 {
    static constexpr bool PERM = true, AFTER_DRAIN = false;
    bf16_t* O; int ldc;
    __device__ __forceinline__ void operator()(const f32x4 (&acc)[2][2][4][2], const Unit& u, int wr, int wc, int fr, int fq) const {
        const int row0 = u.pm * BM + wr * 64 + fr, col0 = u.pn * BM + wc * 32 + 8 * fq;
#pragma unroll
        for (int ai = 0; ai < 2; ++ai)
#pragma unroll
            for (int m = 0; m < 4; ++m) { bf16_t* rowp = O + (size_t)(row0 + ai * HALF + m * 16) * ldc + col0;
#pragma unroll
                for (int bj = 0; bj < 2; ++bj) { f32x4 v0 = acc[ai][bj][m][0], v1 = acc[ai][bj][m][1];
                    if (ACT == 1) {
#pragma unroll
                        for (int e = 0; e < 4; ++e) { const float a = fmaxf(v0[e], 0.f), b = fmaxf(v1[e], 0.f); v0[e] = a * a; v1[e] = b * b; } }
                    u32x4 w; w.x = cvt_pk_bf16(v0[0], v0[1]); w.y = cvt_pk_bf16(v0[2], v0[3]); w.z = cvt_pk_bf16(v1[0], v1[1]); w.w = cvt_pk_bf16(v1[2], v1[3]);
                    *(u32x4*)(rowp + bj * HALF) = w; } }
    }
};

struct EpiF32 {
    static constexpr bool PERM = false, AFTER_DRAIN = false;
    float* C; int ldc;
    __device__ __forceinline__ void operator()(const f32x4 (&acc)[2][2][4][2], const Unit& u, int wr, int wc, int fr, int fq) const {
        const int row0 = u.pm * BM + wr * 64 + fr, col0 = u.pn * BM + wc * 32 + 4 * fq;
#pragma unroll
        for (int ai = 0; ai < 2; ++ai)
#pragma unroll
            for (int m = 0; m < 4; ++m) { float* rowp = C + (size_t)(row0 + ai * HALF + m * 16) * ldc + col0;
#pragma unroll
                for (int bj = 0; bj < 2; ++bj)
#pragma unroll
                    for (int n = 0; n < 2; ++n) *(f32x4*)(rowp + bj * HALF + n * 16) = acc[ai][bj][m][n]; }
    }
};

struct EpiLow {
    static constexpr bool PERM = true, AFTER_DRAIN = false;
    bf16_t* O; int ldc; const float* w0; const float* a0;
    __device__ __forceinline__ void operator()(const f32x4 (&acc)[2][2][4][2], const Unit& u, int wr, int wc, int fr, int fq) const {
        const int row0 = u.pm * BM + wr * 64 + fr, col0 = u.pn * BM + wc * 32 + 8 * fq;
        const int typ = u.pn >> 1, pc0 = (u.pn & 1) * BM + wc * 32 + 8 * fq;
        const float* par = (typ == 0 ? w0 : a0) + pc0;
        const float sc = typ == 0 ? 0.6065306597126334f : 1.0f;
#pragma unroll
        for (int bj = 0; bj < 2; ++bj) {
            f32x4 b0 = (f32x4){0.f, 0.f, 0.f, 0.f}, b1 = b0;
            if (typ < 2) { b0 = *(const f32x4*)(par + bj * HALF); b1 = *(const f32x4*)(par + bj * HALF + 4); }
#pragma unroll
            for (int ai = 0; ai < 2; ++ai)
#pragma unroll
                for (int m = 0; m < 4; ++m) { bf16_t* rowp = O + (size_t)(row0 + ai * HALF + m * 16) * ldc + col0;
                    f32x4 v0 = acc[ai][bj][m][0] + b0, v1 = acc[ai][bj][m][1] + b1;
                    if (typ < 2) {
#pragma unroll
                        for (int e = 0; e < 4; ++e) { v0[e] = sc / (1.f + __expf(-v0[e])); v1[e] = sc / (1.f + __expf(-v1[e])); } }
                    u32x4 w; w.x = cvt_pk_bf16(v0[0], v0[1]); w.y = cvt_pk_bf16(v0[2], v0[3]); w.z = cvt_pk_bf16(v1[0], v1[1]); w.w = cvt_pk_bf16(v1[2], v1[3]);
                    *(u32x4*)(rowp + bj * HALF) = w; }
        }
    }
};

template <class Epi, class Sched, bool ALIGN_EPI = false, bool SP2 = false>
__device__ __forceinline__ void gemm_phase(PG8_LAS unsigned char* lds, const Gemm g, const Sched& S, const Epi& E) {
    const int tid = threadIdx.x, wid = __builtin_amdgcn_readfirstlane(tid >> 6), lane = tid & 63, wr = wid >> 2, wc = wid & 3, fr = lane & 15, fq = lane >> 4;
    const int K = g.K, nt = K / BK;
    unsigned voffA[2], voffB[2];
#pragma unroll
    for (int i = 0; i < 2; ++i) { int R, C; stage_rc(tid * 16 + i * 8192, R, C); const int Rb = Epi::PERM ? ((R & ~31) + perm32(R & 31)) : R;
        voffA[i] = (unsigned)(R * K + C) * 2u; voffB[i] = (unsigned)(Rb * K + C) * 2u; }
    const size_t kstep = (size_t)(BK * 2);
    const size_t hstep = (size_t)HALF * K * 2;
    const size_t tstep = 2 * hstep;
    const unsigned ldsw = (unsigned)wid * 1024u;
    const int aoff = lds_byte(wr * 64 + fr, fq * 8), boff = lds_byte(wc * 32 + fr, fq * 8);
#define PG8_SA(b, h) (((b) * 2 + (h)) * HTB)
#define PG8_SB(b, h) ((4 + (b) * 2 + (h)) * HTB)
#define PG8_STAGE(bufoff, gbase, voff) do { _Pragma("unroll") for (int _i = 0; _i < 2; ++_i) \
        __builtin_amdgcn_global_load_lds((const unsigned*)((const char*)(gbase) + (voff)[_i]), (PG8_LAS unsigned*)(lds + (bufoff) + ldsw + _i * 8192), 16, 0, 0); } while (0)
#define PG8_LDA(dst, b, h) do { _Pragma("unroll") for (int m = 0; m < 4; ++m) _Pragma("unroll") for (int k = 0; k < 2; ++k) dst[m][k] = *(const PG8_LAS bf16x8*)(lds + PG8_SA(b, h) + aoff + m * 2048 + k * 1024); } while (0)
#define PG8_LDB(dst, b, h) do { _Pragma("unroll") for (int n = 0; n < 2; ++n) _Pragma("unroll") for (int k = 0; k < 2; ++k) dst[n][k] = *(const PG8_LAS bf16x8*)(lds + PG8_SB(b, h) + boff + n * 2048 + k * 1024); } while (0)
#define PG8_MMA(ai, bj, At, Bt) do { __builtin_amdgcn_s_setprio(1); _Pragma("unroll") for (int m = 0; m < 4; ++m) _Pragma("unroll") for (int n = 0; n < 2; ++n) _Pragma("unroll") for (int k = 0; k < 2; ++k) \
        acc[ai][bj][m][n] = __builtin_amdgcn_mfma_f32_16x16x32_bf16(Bt[n][k], At[m][k], acc[ai][bj][m][n], 0, 0, 0); __builtin_amdgcn_s_setprio(0); } while (0)
#define PG8_WAIT_V(n) asm volatile("s_waitcnt vmcnt(" #n ")" ::: "memory")
#define PG8_WAIT_L(n) asm volatile("s_waitcnt lgkmcnt(" #n ")" ::: "memory")
#define PG8_BAR __builtin_amdgcn_s_barrier()
#define PG8_SCHED __builtin_amdgcn_sched_barrier(0)
    Unit cur, nxt; int ui = 0;
    if (!S.next(0, cur)) return;
    f32x4 acc[2][2][4][2];
#pragma unroll
    for (int a = 0; a < 2; ++a)
#pragma unroll
        for (int b = 0; b < 2; ++b)
#pragma unroll
            for (int m = 0; m < 4; ++m)
#pragma unroll
                for (int n = 0; n < 2; ++n) acc[a][b][m][n] = (f32x4){0.f, 0.f, 0.f, 0.f};
    bf16x8 At[4][2], B0[2][2], B1[2][2];
    const char* cA = (const char*)g.A + (size_t)cur.pm * tstep; const char* cB = (const char*)g.Bt + (size_t)cur.pn * tstep;
    S.a_ready(cur);
    if constexpr (SP2) {
        PG8_STAGE(PG8_SB(0, 0), cB, voffB); PG8_STAGE(PG8_SB(0, 1), cB + hstep, voffB); PG8_STAGE(PG8_SA(0, 0), cA, voffA); PG8_STAGE(PG8_SA(0, 1), cA + hstep, voffA);
        if (wr == 1) PG8_BAR;
        PG8_WAIT_V(2); PG8_BAR;
        PG8_STAGE(PG8_SB(1, 0), cB + kstep, voffB); PG8_STAGE(PG8_SA(1, 0), cA + kstep, voffA); PG8_STAGE(PG8_SB(1, 1), cB + hstep + kstep, voffB);
        PG8_WAIT_V(6); PG8_BAR;
    } else {
        PG8_STAGE(PG8_SB(0, 0), cB, voffB); PG8_STAGE(PG8_SA(0, 0), cA, voffA); PG8_STAGE(PG8_SB(0, 1), cB + hstep, voffB); PG8_STAGE(PG8_SA(0, 1), cA + hstep, voffA);
        if (wr == 1) PG8_BAR;
        PG8_WAIT_V(4); PG8_BAR;
        PG8_STAGE(PG8_SB(1, 0), cB + kstep, voffB); PG8_STAGE(PG8_SA(1, 0), cA + kstep, voffA); PG8_STAGE(PG8_SB(1, 1), cB + hstep + kstep, voffB);
        PG8_WAIT_V(6); PG8_BAR;
    }
    for (;;) {
        const bool has_next = S.next(ui + 1, nxt);
        const char* nA = has_next ? (const char*)g.A + (size_t)nxt.pm * tstep : cA; const char* nB = has_next ? (const char*)g.Bt + (size_t)nxt.pn * tstep : cB;
#pragma nounroll
        for (int t = 0; t < nt; t += 2) {
            const bool last = (t == nt - 2);
            const char* a1 = cA + (size_t)(t + 1) * kstep;
            const char* a2 = last ? nA : cA + (size_t)(t + 2) * kstep; const char* b2 = last ? nB : cB + (size_t)(t + 2) * kstep;
            const char* a3 = a2 + kstep; const char* b3 = b2 + kstep;
            if (last && has_next) S.a_ready(nxt);
            if constexpr (SP2) {
            PG8_LDB(B0, 0, 0); PG8_LDB(B1, 0, 1); PG8_SCHED; PG8_LDA(At, 0, 0); PG8_STAGE(PG8_SA(1, 1), a1 + hstep, voffA);
            PG8_WAIT_V(8); PG8_WAIT_L(0); PG8_BAR; PG8_MMA(0, 0, At, B0); PG8_MMA(0, 1, At, B1); PG8_BAR; PG8_SCHED;
            PG8_LDA(At, 0, 1); PG8_STAGE(PG8_SB(0, 0), b2, voffB); PG8_STAGE(PG8_SB(0, 1), b2 + hstep, voffB); PG8_STAGE(PG8_SA(0, 0), a2, voffA);
            PG8_WAIT_V(8); PG8_WAIT_L(0); PG8_BAR; PG8_MMA(1, 0, At, B0); PG8_MMA(1, 1, At, B1); PG8_BAR; PG8_SCHED;
            PG8_LDB(B0, 1, 0); PG8_LDB(B1, 1, 1); PG8_SCHED; PG8_LDA(At, 1, 0); PG8_STAGE(PG8_SA(0, 1), a2 + hstep, voffA);
            PG8_WAIT_V(8); PG8_WAIT_L(0); PG8_BAR; PG8_MMA(0, 0, At, B0); PG8_MMA(0, 1, At, B1); PG8_BAR; PG8_SCHED;
            PG8_LDA(At, 1, 1); PG8_STAGE(PG8_SB(1, 0), b3, voffB); PG8_STAGE(PG8_SB(1, 1), b3 + hstep, voffB); PG8_STAGE(PG8_SA(1, 0), a3, voffA);
            PG8_WAIT_V(8); PG8_WAIT_L(0); PG8_BAR; PG8_MMA(1, 0, At, B0); PG8_MMA(1, 1, At, B1); PG8_BAR; PG8_SCHED;
            } else {
            PG8_LDB(B0, 0, 0); PG8_SCHED; PG8_LDA(At, 0, 0); PG8_STAGE(PG8_SA(1, 1), a1 + hstep, voffA);
            PG8_WAIT_L(8); PG8_BAR; PG8_WAIT_L(0); PG8_MMA(0, 0, At, B0); PG8_BAR; PG8_SCHED;
            PG8_LDB(B1, 0, 1); PG8_STAGE(PG8_SB(0, 0), b2, voffB);
            PG8_BAR; PG8_WAIT_L(0); PG8_MMA(0, 1, At, B1); PG8_BAR;
            PG8_LDA(At, 0, 1); PG8_STAGE(PG8_SA(0, 0), a2, voffA);
            PG8_BAR; PG8_WAIT_L(0); PG8_MMA(1, 0, At, B0); PG8_BAR; PG8_SCHED;
            PG8_STAGE(PG8_SB(0, 1), b2 + hstep, voffB);
            PG8_WAIT_V(6); PG8_BAR; PG8_MMA(1, 1, At, B1); PG8_BAR;
            PG8_LDB(B0, 1, 0); PG8_SCHED; PG8_LDA(At, 1, 0); PG8_STAGE(PG8_SA(0, 1), a2 + hstep, voffA);
            PG8_WAIT_L(8); PG8_BAR; PG8_WAIT_L(0); PG8_MMA(0, 0, At, B0); PG8_BAR; PG8_SCHED;
            PG8_LDB(B1, 1, 1); PG8_STAGE(PG8_SB(1, 0), b3, voffB);
            PG8_BAR; PG8_WAIT_L(0); PG8_MMA(0, 1, At, B1); PG8_BAR;
            PG8_LDA(At, 1, 1); PG8_STAGE(PG8_SA(1, 0), a3, voffA);
            PG8_BAR; PG8_WAIT_L(0); PG8_MMA(1, 0, At, B0); PG8_BAR; PG8_SCHED;
            PG8_STAGE(PG8_SB(1, 1), b3 + hstep, voffB);
            PG8_WAIT_V(6); PG8_BAR; PG8_MMA(1, 1, At, B1); PG8_BAR;
            }
        }
        if constexpr (ALIGN_EPI) { if (wr == 0) PG8_BAR; }
        if constexpr (!Epi::AFTER_DRAIN) { E(acc, cur, wr, wc, fr, fq); S.done(cur); }
        if (!has_next) break;
#pragma unroll
        for (int a = 0; a < 2; ++a)
#pragma unroll
            for (int b = 0; b < 2; ++b)
#pragma unroll
                for (int m = 0; m < 4; ++m)
#pragma unroll
                    for (int n = 0; n < 2; ++n) acc[a][b][m][n] = (f32x4){0.f, 0.f, 0.f, 0.f};
        cur = nxt; cA = nA; cB = nB; ++ui;
        if constexpr (ALIGN_EPI) { if (wr == 1) PG8_BAR; }
    }
    PG8_WAIT_V(0);
    if constexpr (!ALIGN_EPI) { if (wr == 0) PG8_BAR; }
    PG8_BAR;
    if constexpr (Epi::AFTER_DRAIN) { E.fused(acc, cur, wr, wc, fr, fq, lds, wid, lane); S.done(cur); }
#undef PG8_SA
#undef PG8_SB
#undef PG8_STAGE
#undef PG8_LDA
#undef PG8_LDB
#undef PG8_MMA
#undef PG8_WAIT_V
#undef PG8_WAIT_L
#undef PG8_BAR
#undef PG8_SCHED
}
}
#define GAS __attribute__((address_space(1)))
#define LAS __attribute__((address_space(3)))
typedef unsigned short bf16;
typedef unsigned v4u __attribute__((ext_vector_type(4)));
typedef float f32x4 __attribute__((ext_vector_type(4)));
typedef short bf16x8 __attribute__((ext_vector_type(8)));
typedef GAS unsigned gu32;
typedef GAS unsigned long long gu64;
#define RLX_AGENT __ATOMIC_RELAXED, __HIP_MEMORY_SCOPE_AGENT
#define LDS_WAIT() asm volatile("s_waitcnt lgkmcnt(0)" ::: "memory")
#define VM_WAIT() asm volatile("s_waitcnt vmcnt(0)" ::: "memory")
__device__ __forceinline__ unsigned long long rt() { return __builtin_amdgcn_s_memrealtime(); }
__device__ __forceinline__ unsigned f2bf(float f) { unsigned u = __builtin_bit_cast(unsigned, f); return (u + 0x7fffu + ((u >> 16) & 1u)) >> 16; }
__device__ __forceinline__ unsigned pk2(float lo, float hi) { return f2bf(lo) | (f2bf(hi) << 16); }
typedef unsigned v2u __attribute__((ext_vector_type(2)));
#define XB_TMO      128
#define XB_XCNT(j)  (256  + 64 * (j))
#define XB_XSUB(j)  (1280 + 64 * (j))
#define XB_XGEN(j)  (2304 + 64 * (j))
#define XB_TOP      3328
#define XB_TOPGEN   3392
#define XCD_BAR_WORDS 3456
#define XB_SPIN_CAP (1u << 18)

__device__ __forceinline__ unsigned xb_ld(unsigned* p)              { return __hip_atomic_load(p, __ATOMIC_RELAXED, __HIP_MEMORY_SCOPE_AGENT); }
__device__ __forceinline__ unsigned xb_add(unsigned* p, unsigned v) { return __hip_atomic_fetch_add(p, v, __ATOMIC_RELAXED, __HIP_MEMORY_SCOPE_AGENT); }
__device__ __forceinline__ unsigned xb_xcc_id() { return (unsigned)__builtin_amdgcn_s_getreg((3 << 11) | 20) & 0xFu; }
#define XB_SPIN(cond, bar) do { unsigned _sp = 0; while (cond) { __builtin_amdgcn_s_sleep(1); \
    if ((++_sp & 255u) == 0u) { if (xb_ld(&(bar)[XB_TMO])) break; if (_sp > XB_SPIN_CAP) { atomicAdd(&(bar)[XB_TMO], 1u); break; } } } } while (0)

struct XcdBarrier {
    unsigned* bar; unsigned x;
    volatile LAS unsigned* st;
};

__device__ __forceinline__ XcdBarrier xcd_barrier_post(unsigned* bar, volatile LAS unsigned* st) {
    XcdBarrier b; b.bar = bar; b.x = xb_xcc_id(); b.st = st;
    if (threadIdx.x == 0) (void)xb_add(&bar[XB_XCNT(b.x)], 1u);
    return b;
}
__device__ __forceinline__ void xcd_barrier_complete(unsigned* bar, unsigned x, unsigned& nloc, unsigned& nx) {
    const unsigned G = gridDim.x * gridDim.y * gridDim.z;
    unsigned sum, cnt, mine, sp = 0u;
    for (;;) {
        sum = 0u; cnt = 0u; mine = 0u;
#pragma unroll
        for (unsigned j = 0; j < 16; ++j) { const unsigned c = xb_ld(&bar[XB_XCNT(j)]); sum += c; cnt += (c > 0u) ? 1u : 0u; mine = (j == x) ? c : mine; }
        if (sum == G) break;
        __builtin_amdgcn_s_sleep(1);
        if ((++sp & 255u) == 0u) { if (xb_ld(&bar[XB_TMO])) break; if (sp > XB_SPIN_CAP) { atomicAdd(&bar[XB_TMO], 1u); break; } }
    }
    nloc = mine > 0u ? mine : 1u; nx = cnt > 0u ? cnt : 1u;
}

__device__ __forceinline__ void xcd_barrier(const XcdBarrier& b) {
    asm volatile("s_waitcnt vmcnt(0)" ::: "memory");
    __syncthreads();
    if (threadIdx.x == 0) {
        unsigned* bar = b.bar;
        __builtin_amdgcn_s_waitcnt(0);
        unsigned nloc = b.st[0], nx = b.st[1];
        if (nloc == 0u) { xcd_barrier_complete(bar, b.x, nloc, nx); b.st[0] = nloc; b.st[1] = nx; }
        const unsigned old = xb_add(&bar[XB_XSUB(b.x)], 1u);
        const unsigned gen = old / nloc;
        if (old + 1u == (gen + 1u) * nloc) {
            __builtin_amdgcn_fence(__ATOMIC_RELEASE, "agent");
            asm volatile("s_waitcnt vmcnt(0)" ::: "memory");
            const unsigned og = xb_add(&bar[XB_TOP], 1u);
            const unsigned tg = og / nx;
            if (og + 1u == (tg + 1u) * nx) xb_add(&bar[XB_TOPGEN], 1u);
            else XB_SPIN(xb_ld(&bar[XB_TOPGEN]) == tg, bar);
            __builtin_amdgcn_fence(__ATOMIC_ACQUIRE, "agent");
            xb_add(&bar[XB_XGEN(b.x)], 1u);
            asm volatile("s_waitcnt vmcnt(0)" ::: "memory");
        } else {
            XB_SPIN(xb_ld(&bar[XB_XGEN(b.x)]) == gen, bar);
            __builtin_amdgcn_fence(__ATOMIC_ACQUIRE, "agent");
            asm volatile("s_waitcnt vmcnt(0)" ::: "memory");
        }
    }
    __syncthreads();
}
__device__ __forceinline__ void p0_transpose_item(const float* W, int K, int N, bf16* WT, int row_off, LAS float* scr, int item, int lane) {
    const int nblk = N / 32, kb = item / nblk, nb = item % nblk, k0 = 64 * kb, n0 = 32 * nb;
#pragma unroll 8
    for (int i = 0; i < 32; ++i) { const int kk = 2 * i + (lane >> 5); scr[kk * 33 + (lane & 31)] = W[(size_t)(k0 + kk) * N + n0 + (lane & 31)]; }
    LDS_WAIT(); asm volatile("" ::: "memory");
    const int c = lane & 7;
#pragma unroll
    for (int j = 0; j < 4; ++j) { const int n = (lane >> 3) + 8 * j; const LAS float* s = scr + (8 * c) * 33 + n;
        v4u o; o.x = pk2(s[0 * 33], s[1 * 33]); o.y = pk2(s[2 * 33], s[3 * 33]); o.z = pk2(s[4 * 33], s[5 * 33]); o.w = pk2(s[6 * 33], s[7 * 33]);
        *(GAS v4u*)(WT + (size_t)(row_off + n0 + n) * K + k0 + 8 * c) = o; }
    LDS_WAIT(); asm volatile("" ::: "memory");
}

constexpr int NWAVES = 8;
constexpr int NB = 8, T = 2048, M = NB * T, D = 1024, FF = 4096;
constexpr int NP0 = 3360, NP0P = 3584;
constexpr int NLOW = 1536, KLOW = 384;
constexpr int NQKV = 4608, DW = 512;
constexpr int C_R = 0, C_K = 512, C_V = 1024, C_WD = 1536, C_H = 1824, C_BG = 2336, C_CG = 2848;
constexpr float LN_EPS = 1e-5f, GN_EPS = 64e-5f, ALPHA = 1.4142135623730951f;
constexpr int N_IN = 25;
enum { I_X = 0, I_C, I_ADAW, I_ADAB, I_LNG, I_LNB, I_WIN, I_MU, I_W0, I_WUP, I_A0, I_AUP, I_GUP, I_KK, I_KA, I_RK, I_LNXG, I_LNXB, I_CONVW, I_WOUT0, I_WQKV, I_WOUT1, I_RELB, I_W1, I_W2 };

constexpr size_t MiB = 1u << 20;
constexpr size_t WS_CTL = 0, CTL_ZERO_BYTES = 1 * MiB;
constexpr size_t WS_MOD = 1 * MiB;
constexpr size_t WS_WIN = 2 * MiB, WS_WOUT0 = 9 * MiB, WS_W1A = 11 * MiB, WS_W2A = 19 * MiB, WS_WLOW = 27 * MiB;
constexpr size_t WS_WQKV = 2 * MiB, WS_WOUT1 = 11 * MiB, WS_W1B = 12 * MiB, WS_W2B = 20 * MiB;
constexpr size_t WS_AR = 29 * MiB;
constexpr size_t AR_U = WS_AR + 0 * MiB, AR_P0 = WS_AR + 32 * MiB, AR_EIG = WS_AR + 144 * MiB, AR_ACT = WS_AR + 192 * MiB, AR_Y = WS_AR + 192 * MiB;
constexpr size_t AR_A2 = WS_AR + 0 * MiB, AR_YGA = WS_AR + 32 * MiB;
constexpr size_t AR_U2 = WS_AR + 128 * MiB, AR_H = WS_AR + 0 * MiB, AR_YGB = WS_AR + 128 * MiB;
constexpr size_t AR_U3 = WS_AR + 0 * MiB, AR_QKV = WS_AR + 32 * MiB, AR_O = WS_AR + 176 * MiB, AR_YGC = WS_AR + 0 * MiB;
constexpr size_t WS_END = WS_AR + 224 * MiB;
static_assert(WS_END <= 256 * MiB, "d_ws map");
constexpr int CW_BAR = 4096;

constexpr int RING_OFF = 0, RING_BYTES = 131072;
constexpr int LDSCTL_OFF = RING_BYTES, MISC_OFF = LDSCTL_OFF + 320;
constexpr int LDS_BYTES = 147456;

struct Args { const float* in[N_IN]; float* out; unsigned char* ws; int ph_lo, ph_hi; };
struct Frame {
    LAS unsigned char* lds;
    volatile LAS unsigned* MISC;
    gu32* ctl;
    int tid, lane, wave;
    int vcu, G;
    float* out;
    unsigned char* ws;
};

__device__ __forceinline__ float bf_lo(unsigned u) { return __builtin_bit_cast(float, u << 16); }
__device__ __forceinline__ float bf_hi(unsigned u) { return __builtin_bit_cast(float, u & 0xffff0000u); }
template <int CTRL> __device__ __forceinline__ float dppf(float x) { return __builtin_bit_cast(float, __builtin_amdgcn_update_dpp(0, __builtin_bit_cast(int, x), CTRL, 0xF, 0xF, true)); }
__device__ __forceinline__ float red4(float x) { x += dppf<0xB1>(x); x += dppf<0x4E>(x); return x; }
__device__ __forceinline__ float red8(float x) { x = red4(x); x += dppf<0x141>(x); return x; }
__device__ __forceinline__ float red16(float x) { x = red8(x); x += dppf<0x140>(x); return x; }
__device__ __forceinline__ float wave_sum(float v) {
#pragma unroll
    for (int o = 1; o < 64; o <<= 1) v += __shfl_xor(v, o);
    return v;
}
__device__ __forceinline__ float wave_max(float v) {
#pragma unroll
    for (int o = 1; o < 64; o <<= 1) v = fmaxf(v, __shfl_xor(v, o));
    return v;
}
__device__ __forceinline__ void unpack8(const v4u w, float (&f)[8]) {
    f[0] = bf_lo(w.x); f[1] = bf_hi(w.x); f[2] = bf_lo(w.y); f[3] = bf_hi(w.y); f[4] = bf_lo(w.z); f[5] = bf_hi(w.z); f[6] = bf_lo(w.w); f[7] = bf_hi(w.w);
}
__device__ __forceinline__ v4u pack8(const float (&f)[8]) { v4u w; w.x = pk2(f[0], f[1]); w.y = pk2(f[2], f[3]); w.z = pk2(f[4], f[5]); w.w = pk2(f[6], f[7]); return w; }
__device__ __forceinline__ void ld8f(const float* p, float (&f)[8]) { const f32x4 a = *(const f32x4*)p, b = *(const f32x4*)(p + 4); f[0] = a[0]; f[1] = a[1]; f[2] = a[2]; f[3] = a[3]; f[4] = b[0]; f[5] = b[1]; f[6] = b[2]; f[7] = b[3]; }
__device__ __forceinline__ float sigmoidf_(float x) { return 1.f / (1.f + __expf(-x)); }

__device__ __forceinline__ void phase_mod(Frame& F, const Args& A) {
    LAS float* sc = (LAS float*)F.lds;
    LAS float* part = (LAS float*)(F.lds + 32768);
    const float* c = A.in[I_C];
    for (int i = F.tid; i < NB * D; i += NWAVES * 64) { const int b = i >> 10, k = i & 1023; const float cv = c[i]; sc[k * 8 + b] = cv / (1.f + __expf(-cv)); }
    __syncthreads();
    float* mod = (float*)(F.ws + WS_MOD);
    const int cg = F.lane & 15, kr = F.lane >> 4;
    for (int item = blockIdx.x; item < 192; item += F.G) {
        const int l = item / 96, cc = item % 96;
        const float* W = A.in[I_ADAW] + (size_t)l * D * 6144 + cc * 64 + cg * 4;
        f32x4 acc[8];
#pragma unroll
        for (int b = 0; b < 8; ++b) acc[b] = (f32x4){0.f, 0.f, 0.f, 0.f};
#pragma unroll 4
        for (int i = 0; i < 32; ++i) {
            const int k = F.wave * 128 + i * 4 + kr;
            const f32x4 w = *(const f32x4*)(W + (size_t)k * 6144);
            const f32x4 s0 = *(const LAS f32x4*)(sc + k * 8), s1 = *(const LAS f32x4*)(sc + k * 8 + 4);
#pragma unroll
            for (int b = 0; b < 4; ++b) { acc[b] += w * s0[b]; acc[4 + b] += w * s1[b]; }
        }
#pragma unroll
        for (int b = 0; b < 8; ++b)
#pragma unroll
            for (int j = 0; j < 4; ++j) { float v = acc[b][j]; v += __shfl_xor(v, 16); v += __shfl_xor(v, 32); acc[b][j] = v; }
        if (kr == 0) {
#pragma unroll
            for (int b = 0; b < 8; ++b) *(LAS f32x4*)(part + (F.wave * 8 + b) * 64 + cg * 4) = acc[b];
        }
        __syncthreads();
        { const int b = F.tid >> 6, col = F.tid & 63; float s = 0.f;
#pragma unroll
          for (int w = 0; w < 8; ++w) s += part[(w * 8 + b) * 64 + col];
          mod[((size_t)l * NB + b) * 6144 + cc * 64 + col] = s + A.in[I_ADAB][l * 6144 + cc * 64 + col]; }
        __syncthreads();
    }
}

__device__ __forceinline__ void modulate_row(const float* xrow, const float* sh, const float* sc, bf16* urow, int lane) {
#pragma unroll
    for (int j = 0; j < 4; ++j) { const int c4 = lane + 64 * j;
        const f32x4 x = ((const f32x4*)xrow)[c4], a = ((const f32x4*)sc)[c4], s = ((const f32x4*)sh)[c4];
        const f32x4 u = x * (a + 1.f) + s;
        v2u o; o.x = pk2(u[0], u[1]); o.y = pk2(u[2], u[3]); ((v2u*)urow)[c4] = o; }
}

__device__ __forceinline__ void phase_conv0(Frame& F, const Args& A) {
    LAS float* scr = (LAS float*)(F.lds + RING_OFF + F.wave * 16384);
    const int gw = F.vcu * NWAVES + F.wave, NGW = F.G * NWAVES;
    bf16* WIN = (bf16*)(F.ws + WS_WIN); bf16* WOUT = (bf16*)(F.ws + WS_WOUT0); bf16* W1 = (bf16*)(F.ws + WS_W1A); bf16* W2 = (bf16*)(F.ws + WS_W2A); bf16* WLOW = (bf16*)(F.ws + WS_WLOW);
    constexpr int I_IN = (D / 64) * (NP0 / 32), I_O = (D / 64) * (D / 32), I_1 = (D / 64) * (FF / 32), I_2 = (FF / 64) * (D / 32);
    constexpr int NITEMS = I_IN + I_O + I_1 + I_2;
    for (int it = gw; it < NITEMS; it += NGW) {
        int r = it;
        if (r < I_IN) { p0_transpose_item(A.in[I_WIN], D, NP0, WIN, 0, scr, r, F.lane); continue; } r -= I_IN;
        if (r < I_O) { p0_transpose_item(A.in[I_WOUT0], D, D, WOUT, 0, scr, r, F.lane); continue; } r -= I_O;
        if (r < I_1) { p0_transpose_item(A.in[I_W1], D, FF, W1, 0, scr, r, F.lane); continue; } r -= I_1;
        p0_transpose_item(A.in[I_W2], FF, D, W2, 0, scr, r, F.lane);
    }
    const int gt = F.vcu * NWAVES * 64 + F.tid, NT = F.G * NWAVES * 64;
    for (int i = gt; i < (NP0P - NP0) * D * 2 / 16; i += NT) ((v4u*)(WIN + (size_t)NP0 * D))[i] = (v4u){0u, 0u, 0u, 0u};
    for (int i = gt; i < NLOW * KLOW; i += NT) { const int n = i / KLOW, k = i % KLOW, blk = n >> 9, nn = n & 511; float v = 0.f;
        if (blk == 0) { if (k < 64) v = A.in[I_WUP][k * 512 + nn]; }
        else if (blk == 1) { if (k >= 64 && k < 128) v = A.in[I_AUP][(k - 64) * 512 + nn]; }
        else { if (k >= 128 && k < 288) v = A.in[I_GUP][(k - 128) * 512 + nn]; }
        WLOW[i] = (bf16)f2bf(v); }
    const float* mod = (const float*)(F.ws + WS_MOD);
    bf16* U = (bf16*)(F.ws + AR_U);
    for (int m = gw; m < M; m += NGW) { const float* mb = mod + (size_t)(m >> 11) * 6144; modulate_row(A.in[I_X] + (size_t)m * D, mb, mb + 1024, U + (size_t)m * D, F.lane); }
}

__device__ __forceinline__ void conv1_items(Frame& F, const Args& A) {
    LAS float* scr = (LAS float*)(F.lds + RING_OFF + F.wave * 16384);
    const int gw = F.vcu * NWAVES + F.wave, NGW = F.G * NWAVES;
    bf16* WQ = (bf16*)(F.ws + WS_WQKV); bf16* WO = (bf16*)(F.ws + WS_WOUT1); bf16* W1 = (bf16*)(F.ws + WS_W1B); bf16* W2 = (bf16*)(F.ws + WS_W2B);
    constexpr int I_Q = (D / 64) * (NQKV / 32), I_O = (DW / 64) * (D / 32), I_1 = (D / 64) * (FF / 32), I_2 = (FF / 64) * (D / 32);
    constexpr int NITEMS = I_Q + I_O + I_1 + I_2;
    for (int it = gw; it < NITEMS; it += NGW) {
        int r = it;
        if (r < I_Q) { p0_transpose_item(A.in[I_WQKV], D, NQKV, WQ, 0, scr, r, F.lane); continue; } r -= I_Q;
        if (r < I_O) { p0_transpose_item(A.in[I_WOUT1], DW, D, WO, 0, scr, r, F.lane); continue; } r -= I_O;
        if (r < I_1) { p0_transpose_item(A.in[I_W1] + (size_t)D * FF, D, FF, W1, 0, scr, r, F.lane); continue; } r -= I_1;
        p0_transpose_item(A.in[I_W2] + (size_t)FF * D, FF, D, W2, 0, scr, r, F.lane);
    }
}

__device__ __forceinline__ void phase_act(Frame& F, const Args& A) {
    const int gw = F.vcu * NWAVES + F.wave, NGW = F.G * NWAVES;
    const bf16* P0 = (const bf16*)(F.ws + AR_P0); bf16* ACT = (bf16*)(F.ws + AR_ACT);
    const int lane = F.lane, j0 = 8 * lane;
    float mu[8];
    if (lane < 36) ld8f(A.in[I_MU] + C_WD + j0, mu);
    else {
#pragma unroll
        for (int e = 0; e < 8; ++e) mu[e] = 0.f;
    }
    for (int m = gw; m < M; m += NGW) {
        if (lane < 36) {
            const int t = m & (T - 1);
            float cur[8], prv[8], o[8];
            unpack8(*(const v4u*)(P0 + (size_t)m * NP0P + C_WD + j0), cur);
            if (t > 0) unpack8(*(const v4u*)(P0 + (size_t)(m - 1) * NP0P + C_WD + j0), prv);
            else {
#pragma unroll
                for (int e = 0; e < 8; ++e) prv[e] = 0.f;
            }
#pragma unroll
            for (int e = 0; e < 8; ++e) { const float x = cur[e] + mu[e] * (prv[e] - cur[e]);
                o[e] = (j0 < 64) ? (1.f - 2.f / (__expf(2.f * x) + 1.f)) : (j0 < 128) ? x : sigmoidf_(x); }
            *(v4u*)(ACT + (size_t)m * KLOW + j0) = pack8(o);
        } else if (lane < 48) {
            *(v4u*)(ACT + (size_t)m * KLOW + j0) = (v4u){0u, 0u, 0u, 0u};
        }
    }
}

constexpr int SC_CH = 32, SC_REC = 5 * 64 * 4, SC_BUF = SC_CH * (SC_REC + 64);
__device__ __forceinline__ void scan_produce(Frame& F, const Args& A, int b, int h, int q, int chunk, LAS unsigned char* buf,
                                             const float (&mu_r)[4], const float (&mu_k)[4], const float (&kkc)[4], const float (&kac)[4], const float (&mu_v)[2]) {
    const bf16* P0 = (const bf16*)(F.ws + AR_P0); const bf16* EIG = (const bf16*)(F.ws + AR_EIG);
    const int pw = F.wave - 4, lane = F.lane, seg = lane & 15, kcol = h * 64 + seg * 4;
#pragma unroll
    for (int pass = 0; pass < 2; ++pass) {
        const int tl = pass * 16 + pw * 4 + (lane >> 4), t = chunk * SC_CH + tl; const size_t m = (size_t)b * T + t;
        const v2u rc = *(const v2u*)(P0 + m * NP0P + C_R + kcol), kc = *(const v2u*)(P0 + m * NP0P + C_K + kcol);
        v2u rp = (v2u){0u, 0u}, kp = (v2u){0u, 0u};
        if (t > 0) { rp = *(const v2u*)(P0 + (m - 1) * NP0P + C_R + kcol); kp = *(const v2u*)(P0 + (m - 1) * NP0P + C_K + kcol); }
        const v2u ev = *(const v2u*)(EIG + m * NLOW + kcol), iv = *(const v2u*)(EIG + m * NLOW + 512 + kcol);
        float r4[4], k4[4], e4[4], ic[4], cr[4], pr[4], ck[4], pk[4];
        cr[0] = bf_lo(rc.x); cr[1] = bf_hi(rc.x); cr[2] = bf_lo(rc.y); cr[3] = bf_hi(rc.y);
        pr[0] = bf_lo(rp.x); pr[1] = bf_hi(rp.x); pr[2] = bf_lo(rp.y); pr[3] = bf_hi(rp.y);
        ck[0] = bf_lo(kc.x); ck[1] = bf_hi(kc.x); ck[2] = bf_lo(kc.y); ck[3] = bf_hi(kc.y);
        pk[0] = bf_lo(kp.x); pk[1] = bf_hi(kp.x); pk[2] = bf_lo(kp.y); pk[3] = bf_hi(kp.y);
        e4[0] = bf_lo(ev.x); e4[1] = bf_hi(ev.x); e4[2] = bf_lo(ev.y); e4[3] = bf_hi(ev.y);
        ic[0] = bf_lo(iv.x); ic[1] = bf_hi(iv.x); ic[2] = bf_lo(iv.y); ic[3] = bf_hi(iv.y);
        float kr[4], n2 = 0.f;
#pragma unroll
        for (int e = 0; e < 4; ++e) { r4[e] = cr[e] + mu_r[e] * (pr[e] - cr[e]); k4[e] = ck[e] + mu_k[e] * (pk[e] - ck[e]); kr[e] = k4[e] * kkc[e]; n2 += kr[e] * kr[e]; }
        n2 = red16(n2);
        const float inv = 1.f / fmaxf(sqrtf(n2), 1e-12f);
        f32x4 va, vw, vb, vk, vr;
#pragma unroll
        for (int e = 0; e < 4; ++e) { const float kk = kr[e] * inv; va[e] = -kk; vw[e] = __expf(-e4[e]); vb[e] = kk * ic[e]; vk[e] = k4[e] * (1.f + (ic[e] - 1.f) * kac[e]); vr[e] = r4[e]; }
        LAS float* rec = (LAS float*)(buf + tl * SC_REC) + seg * 4;
        *(LAS f32x4*)(rec) = va; *(LAS f32x4*)(rec + 64) = vw; *(LAS f32x4*)(rec + 128) = vb; *(LAS f32x4*)(rec + 192) = vk; *(LAS f32x4*)(rec + 256) = vr;
    }
    {
        const int ptid = pw * 64 + lane, tl = ptid >> 3, j = (ptid & 7) * 2, t = chunk * SC_CH + tl; const size_t m = (size_t)b * T + t;
        const int col = C_V + h * 64 + q * 16 + j;
        const unsigned vc = *(const unsigned*)(P0 + m * NP0P + col); unsigned vp = 0u;
        if (t > 0) vp = *(const unsigned*)(P0 + (m - 1) * NP0P + col);
        const float c0 = bf_lo(vc), c1 = bf_hi(vc), p0 = bf_lo(vp), p1 = bf_hi(vp);
        LAS float* vb = (LAS float*)(buf + SC_CH * SC_REC) + tl * 16 + j;
        vb[0] = c0 + mu_v[0] * (p0 - c0); vb[1] = c1 + mu_v[1] * (p1 - c1);
    }
}
__device__ __forceinline__ void phase_scan(Frame& F, const Args& A) {
    float* Y = (float*)(F.ws + AR_Y);
    const int lane = F.lane, seg = lane & 15, rg = lane >> 4;
    for (int item = F.vcu; item < NB * 8 * 4; item += F.G) {
        const int bh = item >> 2, q = item & 3, b = bh >> 3, h = bh & 7;
        float mu_r[4], mu_k[4], kkc[4], kac[4], mu_v[2];
        { const int kcol = h * 64 + seg * 4;
#pragma unroll
          for (int e = 0; e < 4; ++e) { mu_r[e] = A.in[I_MU][C_R + kcol + e]; mu_k[e] = A.in[I_MU][C_K + kcol + e]; kkc[e] = A.in[I_KK][kcol + e]; kac[e] = A.in[I_KA][kcol + e]; }
          const int ptid = (F.wave & 3) * 64 + lane, j = (ptid & 7) * 2; mu_v[0] = A.in[I_MU][C_V + h * 64 + q * 16 + j]; mu_v[1] = A.in[I_MU][C_V + h * 64 + q * 16 + j + 1]; }
        LAS unsigned char* buf0 = F.lds, * buf1 = F.lds + SC_BUF;
        if (F.wave >= 4) scan_produce(F, A, b, h, q, 0, buf0, mu_r, mu_k, kkc, kac, mu_v);
        __syncthreads();
        float S0 = 0.f, S1 = 0.f, S2 = 0.f, S3 = 0.f;
        const int row = 4 * F.wave + rg;
        for (int c = 0; c < T / SC_CH; ++c) {
            LAS unsigned char* cur = (c & 1) ? buf1 : buf0; LAS unsigned char* nxt = (c & 1) ? buf0 : buf1;
            if (F.wave >= 4) { if (c + 1 < T / SC_CH) scan_produce(F, A, b, h, q, c + 1, nxt, mu_r, mu_k, kkc, kac, mu_v); }
            else {
                const LAS float* vbase = (const LAS float*)(cur + SC_CH * SC_REC) + row;
                float* yp = Y + ((size_t)b * T + c * SC_CH) * DW + h * 64 + q * 16 + row;
#pragma unroll 4
                for (int tl = 0; tl < SC_CH; ++tl) {
                    const LAS float* rec = (const LAS float*)(cur + tl * SC_REC) + seg * 4;
                    const f32x4 a = *(const LAS f32x4*)(rec), w = *(const LAS f32x4*)(rec + 64), bb = *(const LAS f32x4*)(rec + 128), kk = *(const LAS f32x4*)(rec + 192), r = *(const LAS f32x4*)(rec + 256);
                    const float vv = vbase[tl * 16];
                    float sa = (S0 * a[0] + S1 * a[1]) + (S2 * a[2] + S3 * a[3]);
                    sa = red16(sa);
                    S0 = S0 * w[0] + (sa * bb[0] + vv * kk[0]);
                    S1 = S1 * w[1] + (sa * bb[1] + vv * kk[1]);
                    S2 = S2 * w[2] + (sa * bb[2] + vv * kk[2]);
                    S3 = S3 * w[3] + (sa * bb[3] + vv * kk[3]);
                    float y = (S0 * r[0] + S1 * r[1]) + (S2 * r[2] + S3 * r[3]);
                    y = red16(y);
                    if (seg == 0) yp[(size_t)tl * DW] = y;
                }
            }
            __syncthreads();
        }
    }
}

__device__ __forceinline__ void phase_post(Frame& F, const Args& A) {
    const int gw = F.vcu * NWAVES + F.wave, NGW = F.G * NWAVES, lane = F.lane, c0 = lane * 8;
    const bf16* P0 = (const bf16*)(F.ws + AR_P0); const bf16* EIG = (const bf16*)(F.ws + AR_EIG); const float* Y = (const float*)(F.ws + AR_Y); bf16* A2 = (bf16*)(F.ws + AR_A2);
    float mu_r[8], mu_k[8], mu_v[8], ka[8], rk[8], lg[8], lb[8], cw0[8], cw1[8], cw2[8];
    ld8f(A.in[I_MU] + C_R + c0, mu_r); ld8f(A.in[I_MU] + C_K + c0, mu_k); ld8f(A.in[I_MU] + C_V + c0, mu_v);
    ld8f(A.in[I_KA] + c0, ka); ld8f(A.in[I_RK] + c0, rk); ld8f(A.in[I_LNXG] + c0, lg); ld8f(A.in[I_LNXB] + c0, lb);
    ld8f(A.in[I_CONVW] + c0, cw0); ld8f(A.in[I_CONVW] + 512 + c0, cw1); ld8f(A.in[I_CONVW] + 1024 + c0, cw2);
    for (int m = gw; m < M; m += NGW) {
        const int t = m & (T - 1);
        const bf16* p = P0 + (size_t)m * NP0P; const bf16* pm1 = p - NP0P; const bf16* pm2 = p - 2 * NP0P;
        float rc[8], rp[8], kc[8], kp[8], vc[8], vp[8], ic[8], gt[8], y[8];
        unpack8(*(const v4u*)(p + C_R + c0), rc); unpack8(*(const v4u*)(p + C_K + c0), kc); unpack8(*(const v4u*)(p + C_V + c0), vc);
        if (t > 0) { unpack8(*(const v4u*)(pm1 + C_R + c0), rp); unpack8(*(const v4u*)(pm1 + C_K + c0), kp); unpack8(*(const v4u*)(pm1 + C_V + c0), vp); }
        else {
#pragma unroll
            for (int e = 0; e < 8; ++e) { rp[e] = 0.f; kp[e] = 0.f; vp[e] = 0.f; }
        }
        unpack8(*(const v4u*)(EIG + (size_t)m * NLOW + 512 + c0), ic); unpack8(*(const v4u*)(EIG + (size_t)m * NLOW + 1024 + c0), gt);
        ld8f(Y + (size_t)m * DW + c0, y);
        float bon = 0.f, s = 0.f, vs[8];
#pragma unroll
        for (int e = 0; e < 8; ++e) { const float r = rc[e] + mu_r[e] * (rp[e] - rc[e]), k = kc[e] + mu_k[e] * (kp[e] - kc[e]); vs[e] = vc[e] + mu_v[e] * (vp[e] - vc[e]);
            const float kh = k * (1.f + (ic[e] - 1.f) * ka[e]); bon += r * kh * rk[e]; s += y[e]; }
        bon = red8(bon); s = red8(s);
        const float mean = s * (1.f / 64.f); float q = 0.f;
#pragma unroll
        for (int e = 0; e < 8; ++e) { y[e] -= mean; q += y[e] * y[e]; }
        q = red8(q);
        const float rstd = 1.f / sqrtf(q * (1.f / 64.f) + GN_EPS);
        float o[8];
#pragma unroll
        for (int e = 0; e < 8; ++e) o[e] = (y[e] * rstd * lg[e] + lb[e] + bon * vs[e]) * gt[e];
        *(v4u*)(A2 + (size_t)m * D + c0) = pack8(o);
        float h0[8], g0[8], h1[8], g1[8], h2[8], g2[8], bg[8];
        unpack8(*(const v4u*)(p + C_H + c0), h0); unpack8(*(const v4u*)(p + C_CG + c0), g0); unpack8(*(const v4u*)(p + C_BG + c0), bg);
        if (t > 0) { unpack8(*(const v4u*)(pm1 + C_H + c0), h1); unpack8(*(const v4u*)(pm1 + C_CG + c0), g1); }
        else {
#pragma unroll
            for (int e = 0; e < 8; ++e) { h1[e] = 0.f; g1[e] = 0.f; }
        }
        if (t > 1) { unpack8(*(const v4u*)(pm2 + C_H + c0), h2); unpack8(*(const v4u*)(pm2 + C_CG + c0), g2); }
        else {
#pragma unroll
            for (int e = 0; e < 8; ++e) { h2[e] = 0.f; g2[e] = 0.f; }
        }
#pragma unroll
        for (int e = 0; e < 8; ++e) o[e] = bg[e] * (cw0[e] * (g2[e] * h2[e]) + cw1[e] * (g1[e] * h1[e]) + cw2[e] * (g0[e] * h0[e]));
        *(v4u*)(A2 + (size_t)m * D + 512 + c0) = pack8(o);
    }
}

__device__ __forceinline__ void phase_ln(Frame& F, const float* xin, const float* yg, const float* gmod  , const float* lng, const float* lnb,
                                         float* xout, bf16* U, const float* shmod, const float* scmod) {
    const int gw = F.vcu * NWAVES + F.wave, NGW = F.G * NWAVES, lane = F.lane;
    for (int m = gw; m < M; m += NGW) {
        const int b = m >> 11;
        const f32x4* xr = (const f32x4*)(xin + (size_t)m * D); const f32x4* yr = (const f32x4*)(yg + (size_t)m * D); const f32x4* gr = (const f32x4*)(gmod + (size_t)b * 6144);
        f32x4 v[4]; float s = 0.f;
#pragma unroll
        for (int j = 0; j < 4; ++j) { const int c4 = lane + 64 * j; v[j] = xr[c4] * ALPHA + (gr[c4] + 1.f) * yr[c4]; s += (v[j][0] + v[j][1]) + (v[j][2] + v[j][3]); }
        const float mean = wave_sum(s) * (1.f / D); float s2 = 0.f;
#pragma unroll
        for (int j = 0; j < 4; ++j) { v[j] = v[j] - mean; s2 += (v[j][0] * v[j][0] + v[j][1] * v[j][1]) + (v[j][2] * v[j][2] + v[j][3] * v[j][3]); }
        const float rstd = 1.f / sqrtf(wave_sum(s2) * (1.f / D) + LN_EPS);
#pragma unroll
        for (int j = 0; j < 4; ++j) { const int c4 = lane + 64 * j;
            const f32x4 o = v[j] * rstd * ((const f32x4*)lng)[c4] + ((const f32x4*)lnb)[c4];
            ((f32x4*)(xout + (size_t)m * D))[c4] = o;
            if (U) { const f32x4 u = o * (((const f32x4*)(scmod + (size_t)b * 6144))[c4] + 1.f) + ((const f32x4*)(shmod + (size_t)b * 6144))[c4];
                v2u w; w.x = pk2(u[0], u[1]); w.y = pk2(u[2], u[3]); ((v2u*)(U + (size_t)m * D))[c4] = w; } }
    }
}

__device__ __forceinline__ int t5_bucket(int dist) {
    if (dist < 16) return dist;
    const float logd = __logf((float)dist / 16.f) / 4.852030263919617f;
    const int large = 16 + (int)(logd * 16.f);
    return large < 31 ? large : 31;
}
__device__ __forceinline__ void phase_attn_simple(Frame& F, const Args& A) {
    LAS float* biasT = (LAS float*)F.lds;
    for (int i = F.tid; i < 3 * 8 * 129; i += NWAVES * 64) { const int g = i / (8 * 129), h = (i / 129) & 7, j = i % 129; const int dil = g == 0 ? 1 : g == 1 ? 4 : 16;
        biasT[i] = A.in[I_RELB][t5_bucket(j * dil) * 24 + g * 8 + h]; }
    __syncthreads();
    const bf16* QKV = (const bf16*)(F.ws + AR_QKV); bf16* O = (bf16*)(F.ws + AR_O);
    const int gw = F.vcu * NWAVES + F.wave, NGW = F.G * NWAVES, lane = F.lane;
    for (int item = gw; item < M * 8; item += NGW) {
        const int h = item / M, m = item % M, t = m & (T - 1);
        float sc[3][3]; float mx = -1e30f;
#pragma unroll
        for (int g = 0; g < 3; ++g) {
            const int dil = g == 0 ? 1 : g == 1 ? 4 : 16, ms = t / dil;
            float qf[64];
            { const v4u* qp = (const v4u*)(QKV + (size_t)m * NQKV + g * 1536 + h * 64);
#pragma unroll
              for (int i = 0; i < 8; ++i) { float f[8]; unpack8(qp[i], f);
#pragma unroll
                  for (int e = 0; e < 8; ++e) qf[i * 8 + e] = f[e]; } }
#pragma unroll
            for (int jc = 0; jc < 3; ++jc) {
                const int j = jc < 2 ? lane + 64 * jc : 128;
                const bool valid = (jc < 2 || lane == 0) && (ms - j >= 0);
                float s = -1e30f;
                if (valid) {
                    const v4u* kp = (const v4u*)(QKV + (size_t)(m - j * dil) * NQKV + g * 1536 + 512 + h * 64);
                    float d = 0.f;
#pragma unroll
                    for (int i = 0; i < 8; ++i) { float f[8]; unpack8(kp[i], f);
#pragma unroll
                        for (int e = 0; e < 8; ++e) d += qf[i * 8 + e] * f[e]; }
                    s = d * 0.125f + biasT[(g * 8 + h) * 129 + j];
                }
                sc[g][jc] = s; mx = fmaxf(mx, s);
            }
        }
        mx = wave_max(mx);
        float sum = 0.f;
#pragma unroll
        for (int g = 0; g < 3; ++g)
#pragma unroll
            for (int jc = 0; jc < 3; ++jc) { const float p = sc[g][jc] > -1e29f ? __expf(sc[g][jc] - mx) : 0.f; sc[g][jc] = p; sum += p; }
        sum = wave_sum(sum);
        float acc = 0.f;
#pragma unroll
        for (int g = 0; g < 3; ++g) {
            const int dil = g == 0 ? 1 : g == 1 ? 4 : 16, ms = t / dil;
            const bf16* vb = QKV + (size_t)m * NQKV + g * 1536 + 1024 + h * 64 + lane;
#pragma unroll
            for (int jc = 0; jc < 2; ++jc) {
                const int nj = (ms - 64 * jc + 1) < 64 ? (ms - 64 * jc + 1) : 64;
                for (int jj = 0; jj < nj; ++jj) { const float p = __builtin_bit_cast(float, __builtin_amdgcn_readlane(__builtin_bit_cast(int, sc[g][jc]), jj));
                    const int j = 64 * jc + jj; acc += p * bf_lo((unsigned)vb[-(long)j * dil * NQKV]); }
            }
            if (ms >= 128) { const float p = __builtin_bit_cast(float, __builtin_amdgcn_readlane(__builtin_bit_cast(int, sc[g][2]), 0)); acc += p * bf_lo((unsigned)vb[-(long)128 * dil * NQKV]); }
        }
        O[(size_t)m * DW + h * 64 + lane] = (bf16)f2bf(acc / sum);
    }
}

typedef float f32x16 __attribute__((ext_vector_type(16)));
typedef short v4i16_t __attribute__((ext_vector_type(4)));
constexpr int AT_PITCH = 192, AT_OACC = 0, AT_ML = 65536, AT_BIAS = 67584, AT_SM = 69632, AT_VST = 71680, AT_VSTW = 32 * AT_PITCH;
static_assert(AT_VST + NWAVES * AT_VSTW <= RING_BYTES, "attention LDS map");
__device__ __forceinline__ int crow(int r, int hi) { return (r & 3) + 8 * (r >> 2) + 4 * hi; }

__device__ __forceinline__ void attn_wave_item(Frame& F, const bf16* QKV, int b, int h, int g, int dil, int L, int rr, int m0, int nvalid, int jr, bool first) {
    int lane_ = F.lane; asm volatile("" : "+v"(lane_));
    const int lane = lane_, l31 = lane & 31, hi = lane >> 5;
    LAS float* Oacc = (LAS float*)(F.lds + AT_OACC); LAS float* ML = (LAS float*)(F.lds + AT_ML);
    const LAS float* biasg = (const LAS float*)(F.lds + AT_BIAS) + g * 132;
    LAS float* sm = (LAS float*)(F.lds + AT_SM) + F.wave * 64;
    LAS unsigned char* vst = F.lds + AT_VST + F.wave * AT_VSTW;
    const bf16* base = QKV + (size_t)b * T * NQKV + g * 1536 + h * 64;
    const int mq = m0 + l31, mqc = mq < L ? mq : L - 1;
    bf16x8 qf[4];
    { const bf16* qrow = base + (size_t)(mqc * dil + rr) * NQKV + 8 * hi;
#pragma unroll
      for (int ks = 0; ks < 4; ++ks) qf[ks] = *(const bf16x8*)(qrow + 16 * ks); }
    const LAS float* bp = biasg + (l31 - 4 * hi + 128);
    f32x16 S[5];
#pragma unroll
    for (int kt = 0; kt < 5; ++kt) {
        const int mk0 = m0 - 128 + 32 * kt;
        if (mk0 + 31 >= 0) {
            const int mk = mk0 + l31, mkc = mk < 0 ? 0 : (mk < L ? mk : L - 1);
            const bf16* krow = base + 512 + (size_t)(mkc * dil + rr) * NQKV + 8 * hi;
            bf16x8 kf[4];
#pragma unroll
            for (int ks = 0; ks < 4; ++ks) kf[ks] = *(const bf16x8*)(krow + 16 * ks);
            f32x16 acc;
#pragma unroll
            for (int r = 0; r < 16; ++r) acc[r] = 0.f;
#pragma unroll
            for (int ks = 0; ks < 4; ++ks) acc = __builtin_amdgcn_mfma_f32_32x32x16_bf16(kf[ks], qf[ks], acc, 0, 0, 0);
#pragma unroll
            for (int r = 0; r < 16; ++r) { const int cr = (r & 3) + 8 * (r >> 2);
                const float s = acc[r] * 0.125f + bp[-(32 * kt + cr)];
                bool valid = true;
                if (kt == 0) valid = (cr + 4 * hi >= l31);
                if (kt == 4) valid = (cr + 4 * hi <= l31);
                if (mk0 < 0) valid = valid && (mk0 + cr + 4 * hi >= 0);
                S[kt][r] = valid ? s : -1e30f; }
            asm volatile("" ::: "memory");
        } else {
#pragma unroll
            for (int r = 0; r < 16; ++r) S[kt][r] = -1e30f;
        }
    }
    float mx = -1e30f;
#pragma unroll
    for (int kt = 0; kt < 5; ++kt)
#pragma unroll
        for (int r = 0; r < 16; ++r) mx = fmaxf(mx, S[kt][r]);
    mx = fmaxf(mx, __shfl_xor(mx, 32));
    float lsum = 0.f;
#pragma unroll
    for (int kt = 0; kt < 5; ++kt)
#pragma unroll
        for (int r = 0; r < 16; ++r) { const float p = __expf(S[kt][r] - mx); S[kt][r] = p; lsum += p; }
    lsum += __shfl_xor(lsum, 32);
    f32x16 o0, o1;
#pragma unroll
    for (int r = 0; r < 16; ++r) { o0[r] = 0.f; o1[r] = 0.f; }
    const LAS unsigned char* vaddr = vst + (4 * hi + ((lane & 15) >> 2)) * AT_PITCH + (16 * ((lane >> 4) & 1) + 4 * (lane & 3)) * 2;
#pragma unroll
    for (int kt = 0; kt < 5; ++kt) {
        const int mk0 = m0 - 128 + 32 * kt;
        if (mk0 + 31 >= 0) {
            v4u vv[4];
#pragma unroll
            for (int i = 0; i < 4; ++i) { const int key = 8 * i + (lane >> 3), mk = mk0 + key, mkc = mk < 0 ? 0 : (mk < L ? mk : L - 1);
                vv[i] = *(const v4u*)(base + 1024 + (size_t)(mkc * dil + rr) * NQKV + (lane & 7) * 8); }
            asm volatile("" ::: "memory");
#pragma unroll
            for (int i = 0; i < 4; ++i) { const int key = 8 * i + (lane >> 3); *(LAS v4u*)(vst + key * AT_PITCH + (lane & 7) * 16) = vv[i]; }
            asm volatile("s_waitcnt lgkmcnt(0)" ::: "memory");
            bf16x8 pa[2];
#pragma unroll
            for (int s = 0; s < 2; ++s) { v4u w; w.x = pg8::cvt_pk_bf16(S[kt][8 * s + 0], S[kt][8 * s + 1]); w.y = pg8::cvt_pk_bf16(S[kt][8 * s + 2], S[kt][8 * s + 3]);
                w.z = pg8::cvt_pk_bf16(S[kt][8 * s + 4], S[kt][8 * s + 5]); w.w = pg8::cvt_pk_bf16(S[kt][8 * s + 6], S[kt][8 * s + 7]); pa[s] = __builtin_bit_cast(bf16x8, w); }
#pragma unroll
            for (int s = 0; s < 2; ++s)
#pragma unroll
                for (int dt = 0; dt < 2; ++dt) {
                    const v4i16_t lo = __builtin_amdgcn_ds_read_tr16_b64_v4i16((LAS v4i16_t*)(vaddr + s * 16 * AT_PITCH + dt * 64));
                    const v4i16_t hh = __builtin_amdgcn_ds_read_tr16_b64_v4i16((LAS v4i16_t*)(vaddr + s * 16 * AT_PITCH + 8 * AT_PITCH + dt * 64));
                    const bf16x8 vf = (bf16x8){lo[0], lo[1], lo[2], lo[3], hh[0], hh[1], hh[2], hh[3]};
                    if (dt == 0) o0 = __builtin_amdgcn_mfma_f32_32x32x16_bf16(pa[s], vf, o0, 0, 0, 0);
                    else o1 = __builtin_amdgcn_mfma_f32_32x32x16_bf16(pa[s], vf, o1, 0, 0, 0);
                }
            asm volatile("s_waitcnt lgkmcnt(0)" ::: "memory");
        }
    }
    if (hi == 0) { sm[l31] = mx; sm[32 + l31] = lsum; }
    asm volatile("s_waitcnt lgkmcnt(0)" ::: "memory");
#pragma unroll
    for (int r = 0; r < 16; ++r) {
        const int qi = crow(r, hi);
        if (nvalid == 32 || r < 8) {
            const int tau = (m0 + qi) * dil + rr - 256 * jr;
            const float mw = sm[qi], lw = sm[32 + qi];
            LAS float* orow = Oacc + tau * 64 + l31;
            if (first) { orow[0] = o0[r]; orow[32] = o1[r]; if (l31 == 0) { ML[2 * tau] = mw; ML[2 * tau + 1] = lw; } }
            else { const float Mo = ML[2 * tau], Lo = ML[2 * tau + 1], Mn = fmaxf(Mo, mw), fa = __expf(Mo - Mn), fb = __expf(mw - Mn);
                orow[0] = orow[0] * fa + o0[r] * fb; orow[32] = orow[32] * fa + o1[r] * fb;
                if (l31 == 0) { ML[2 * tau] = Mn; ML[2 * tau + 1] = Lo * fa + lw * fb; } }
        }
    }
    asm volatile("s_waitcnt lgkmcnt(0)" ::: "memory");
}

__device__ __forceinline__ void phase_attn(Frame& F, const Args& A) {
    const bf16* QKV = (const bf16*)(F.ws + AR_QKV); bf16* O = (bf16*)(F.ws + AR_O);
    LAS float* biasT = (LAS float*)(F.lds + AT_BIAS);
    const int w = F.wave;
    for (int item = F.vcu * 2; item < NB * 8 * 8; item += (item & 1) ? 2 * F.G - 1 : 1) {
        const int bh = item >> 3, jr = item & 7, b = bh >> 3, h = bh & 7;
        for (int i = F.tid; i < 3 * 129; i += NWAVES * 64) { const int g = i / 129, j = i % 129, dil = g == 0 ? 1 : g == 1 ? 4 : 16;
            biasT[g * 132 + j] = A.in[I_RELB][t5_bucket(j * dil) * 24 + g * 8 + h]; }
        __syncthreads();
        attn_wave_item(F, QKV, b, h, 0, 1, 2048, 0, 256 * jr + 32 * w, 32, jr, true);
        __syncthreads();
        attn_wave_item(F, QKV, b, h, 1, 4, 512, w & 3, 64 * jr + 32 * (w >> 2), 32, jr, false);
        __syncthreads();
        attn_wave_item(F, QKV, b, h, 2, 16, 128, w, 16 * jr, 16, jr, false);
        attn_wave_item(F, QKV, b, h, 2, 16, 128, w + 8, 16 * jr, 16, jr, false);
        __syncthreads();
        {
            const int tau = F.tid >> 1, half = F.tid & 1;
            const LAS float* orow = (const LAS float*)(F.lds + AT_OACC) + tau * 64 + half * 32;
            const float inv = 1.f / ((const LAS float*)(F.lds + AT_ML))[2 * tau + 1];
            bf16* dst = O + ((size_t)b * T + 256 * jr + tau) * DW + h * 64 + half * 32;
#pragma unroll
            for (int c = 0; c < 4; ++c) { const f32x4 a = *(const LAS f32x4*)(orow + 8 * c), bb = *(const LAS f32x4*)(orow + 8 * c + 4);
                v4u o; o.x = pk2(a[0] * inv, a[1] * inv); o.y = pk2(a[2] * inv, a[3] * inv); o.z = pk2(bb[0] * inv, bb[1] * inv); o.w = pk2(bb[2] * inv, bb[3] * inv);
                *(v4u*)(dst + 8 * c) = o; }
        }
        __syncthreads();
    }
}

#ifndef MK_SINGLE
#define MK_SINGLE 1
#endif
constexpr int N_PHASES = 19;
enum { PH_MOD = 0, PH_CONV0, PH_G_IN, PH_ACT, PH_G_LOW, PH_SCAN, PH_POST, PH_G_OUT0, PH_LN1, PH_G_UP0, PH_G_DN0, PH_LN2, PH_G_QKV, PH_ATTN, PH_G_OUT1, PH_LN3, PH_G_UP1, PH_G_DN1, PH_LN4 };

__global__ void __launch_bounds__(NWAVES * 64, 2) fwd_kernel(Args args) {
    extern __shared__ __attribute__((aligned(16))) unsigned char lds[];
    Frame F;
    F.lds = (LAS unsigned char*)lds;
    F.MISC = (volatile LAS unsigned*)(F.lds + MISC_OFF);
    F.tid = threadIdx.x; F.lane = F.tid & 63; F.wave = __builtin_amdgcn_readfirstlane(F.tid >> 6);
    F.G = gridDim.x; { const int bx = blockIdx.x; F.vcu = (F.G % 8 == 0) ? (bx % 8) * (F.G / 8) + bx / 8 : bx; }
    F.ws = args.ws; F.out = args.out; F.ctl = (gu32*)(args.ws + WS_CTL);
    for (int u = F.tid; u < (LDS_BYTES - LDSCTL_OFF) / 4; u += NWAVES * 64) ((LAS unsigned*)(F.lds + LDSCTL_OFF))[u] = 0u;
    __syncthreads();
    const int lo = args.ph_lo, hi = args.ph_hi;
    XcdBarrier bar; bar.bar = (unsigned*)(F.ctl + CW_BAR); bar.x = 0; bar.st = nullptr;
    if (hi - lo > 1) bar = xcd_barrier_post((unsigned*)(F.ctl + CW_BAR), F.MISC + 8);

    unsigned char* ws = args.ws;
    float* mod = (float*)(ws + WS_MOD);
#ifndef PH_MASK
#define PH_MASK 0x7ffff
#endif
#define PHON(k) (((PH_MASK) >> (k)) & 1)
#define IN(k) (PHON(k) && lo <= (k) && (k) < hi)
#define PHASE_BEGIN() do { int t_ = threadIdx.x; asm volatile("" : "+v"(t_)); F.tid = t_; F.lane = t_ & 63; F.wave = __builtin_amdgcn_readfirstlane(t_ >> 6); \
        unsigned long long wi_ = (unsigned long long)args.ws; asm volatile("" : "+s"(wi_)); unsigned char* w_ = (unsigned char*)(GAS unsigned char*)wi_; ws = w_; F.ws = w_; mod = (float*)(w_ + WS_MOD); } while (0)
#ifndef REP_MASK
#define REP_MASK 0
#endif
#define RUN(k, ...) do { if (IN(k)) { for (int rep_ = 0; rep_ < ((((REP_MASK) >> (k)) & 1) ? 2 : 1); ++rep_) { PHASE_BEGIN(); __VA_ARGS__ \
        if ((k) + 1 < hi || rep_ == 0 && (((REP_MASK) >> (k)) & 1)) xcd_barrier(bar); } } } while (0)
#define GEMM_PHASE(EPI, Aoff, Boff, N_, K_, ...) do { pg8::Gemm g{(const bf16*)(ws + (Aoff)), (const bf16*)(ws + (Boff)), M, (N_), (K_)}; \
        pg8::StaticOrder S; S.init(M, (N_), F.G, (int)blockIdx.x); EPI E{__VA_ARGS__}; \
        pg8::gemm_phase<EPI, pg8::StaticOrder, true, true>(F.lds + RING_OFF, g, S, E); } while (0)

    RUN(PH_MOD, { phase_mod(F, args); });
    RUN(PH_CONV0, { phase_conv0(F, args); });
    RUN(PH_G_IN, { GEMM_PHASE(pg8::EpiBf16<0>, AR_U, WS_WIN, NP0P, D, (bf16*)(ws + AR_P0), NP0P); });
    RUN(PH_ACT, { phase_act(F, args); });
    RUN(PH_G_LOW, { GEMM_PHASE(pg8::EpiLow, AR_ACT, WS_WLOW, NLOW, KLOW, (bf16*)(ws + AR_EIG), NLOW, args.in[I_W0], args.in[I_A0]); });
    RUN(PH_SCAN, { phase_scan(F, args); });
    RUN(PH_POST, { phase_post(F, args); });
    RUN(PH_G_OUT0, { GEMM_PHASE(pg8::EpiF32, AR_A2, WS_WOUT0, D, D, (float*)(ws + AR_YGA), D); });
    RUN(PH_LN1, { phase_ln(F, args.in[I_X], (const float*)(ws + AR_YGA), mod + 2048, args.in[I_LNG], args.in[I_LNB], F.out, (bf16*)(ws + AR_U2), mod + 3072, mod + 4096); });
    RUN(PH_G_UP0, { GEMM_PHASE(pg8::EpiBf16<1>, AR_U2, WS_W1A, FF, D, (bf16*)(ws + AR_H), FF); });
    RUN(PH_G_DN0, { GEMM_PHASE(pg8::EpiF32, AR_H, WS_W2A, D, FF, (float*)(ws + AR_YGB), D); });
    RUN(PH_LN2, { conv1_items(F, args);
                         phase_ln(F, F.out, (const float*)(ws + AR_YGB), mod + 5120, args.in[I_LNG] + 1024, args.in[I_LNB] + 1024, F.out, (bf16*)(ws + AR_U3), mod + NB * 6144, mod + NB * 6144 + 1024); });
    RUN(PH_G_QKV, { GEMM_PHASE(pg8::EpiBf16<0>, AR_U3, WS_WQKV, NQKV, D, (bf16*)(ws + AR_QKV), NQKV); });
    #ifdef ATTN_SIMPLE
    RUN(PH_ATTN, { phase_attn_simple(F, args); });
#else
    RUN(PH_ATTN, { phase_attn(F, args); });
#endif
    RUN(PH_G_OUT1, { GEMM_PHASE(pg8::EpiF32, AR_O, WS_WOUT1, D, DW, (float*)(ws + AR_YGC), D); });
    RUN(PH_LN3, { phase_ln(F, F.out, (const float*)(ws + AR_YGC), mod + NB * 6144 + 2048, args.in[I_LNG] + 2048, args.in[I_LNB] + 2048, F.out, (bf16*)(ws + AR_U2), mod + NB * 6144 + 3072, mod + NB * 6144 + 4096); });
    RUN(PH_G_UP1, { GEMM_PHASE(pg8::EpiBf16<1>, AR_U2, WS_W1B, FF, D, (bf16*)(ws + AR_H), FF); });
    RUN(PH_G_DN1, { GEMM_PHASE(pg8::EpiF32, AR_H, WS_W2B, D, FF, (float*)(ws + AR_YGB), D); });
    RUN(PH_LN4, { phase_ln(F, F.out, (const float*)(ws + AR_YGB), mod + NB * 6144 + 5120, args.in[I_LNG] + 3072, args.in[I_LNB] + 3072, F.out, (bf16*)nullptr, mod, mod); });
}

extern "C" void kernel_launch(void* const* d_in, const int* in_sizes, int n_in, void* d_out, int out_size, void* d_ws, size_t ws_size, hipStream_t stream) {
    static int grid = 0;
    if (grid == 0) {
        if (n_in != N_IN || in_sizes[0] != M * D || out_size != M * D || ws_size < WS_END) {
            fprintf(stderr, "kernel_launch: unexpected problem: n_in %d in0 %d out %d ws %zu (need %zu); nothing launched\n", n_in, n_in > 0 ? in_sizes[0] : -1, out_size, ws_size, (size_t)WS_END); grid = -1; return; }
        int dev = 0, cus = 0, per_cu = 0;
        if (hipGetDevice(&dev) != hipSuccess || hipDeviceGetAttribute(&cus, hipDeviceAttributeMultiprocessorCount, dev) != hipSuccess) { fprintf(stderr, "kernel_launch: device query failed\n"); grid = -1; return; }
        if (hipFuncSetAttribute((const void*)fwd_kernel, hipFuncAttributeMaxDynamicSharedMemorySize, LDS_BYTES) != hipSuccess) { fprintf(stderr, "kernel_launch: hipFuncSetAttribute failed\n"); grid = -1; return; }
        if (hipOccupancyMaxActiveBlocksPerMultiprocessor(&per_cu, (const void*)fwd_kernel, NWAVES * 64, LDS_BYTES) != hipSuccess || per_cu < 1) { fprintf(stderr, "kernel_launch: occupancy query says %d blocks per CU\n", per_cu); per_cu = 1; }
        (void)hipGetLastError();
        grid = cus * (per_cu < 1 ? 1 : per_cu);
        if (grid > cus) grid = cus;
    }
    if (grid < 0) return;
    (void)hipMemsetAsync((char*)d_ws + WS_CTL, 0, CTL_ZERO_BYTES, stream);
    Args a{};
    for (int i = 0; i < N_IN; ++i) a.in[i] = (const float*)d_in[i];
    a.out = (float*)d_out; a.ws = (unsigned char*)d_ws;
#if MK_SINGLE
    a.ph_lo = 0; a.ph_hi = N_PHASES;
    void* kargs[] = {&a};
    hipError_t e = hipLaunchCooperativeKernel((const void*)fwd_kernel, dim3(grid), dim3(NWAVES * 64), kargs, LDS_BYTES, stream);
    if (e != hipSuccess) fprintf(stderr, "kernel_launch: cooperative launch failed: %s (grid %d)\n", hipGetErrorString(e), grid);
#else
    for (int ph = 0; ph < N_PHASES; ++ph) {
        a.ph_lo = ph; a.ph_hi = ph + 1;
        hipLaunchKernelGGL(fwd_kernel, dim3(grid), dim3(NWAVES * 64), LDS_BYTES, stream, a);
    }
#endif
}
```
